# Optimizing an MI355X kernel written in HIP

```python
import jax, jax.numpy as jnp
from jax import lax
import numpy as np

D_MODEL = 1024
BATCH = 8
SEQ = 2048
DEPTH = 1

MEM_LEN = 256
HEAD_DIM = 64
POOL_WINDOWS = (2, 4, 8, 16)
POOL_GROUPS = len(POOL_WINDOWS)
POOL_WIDTH = D_MODEL // 4
POOL_CH = POOL_WIDTH // POOL_GROUPS
SB_WIDTH = D_MODEL // 2
SB_HEADS = SB_WIDTH // HEAD_DIM
MEM_HEADS = 4
MEM_WIDTH = D_MODEL // 4
MEM_HEAD_DIM = MEM_WIDTH // MEM_HEADS
MIX_WIDTH = POOL_WIDTH + SB_WIDTH + MEM_WIDTH
IN_SPLITS = (POOL_WIDTH, POOL_WIDTH, SB_WIDTH, SB_WIDTH, SB_WIDTH, SB_WIDTH, MEM_WIDTH, MEM_WIDTH)
IN_WIDTH = sum(IN_SPLITS)
Q_BLOCK = 128
EPS = 1e-6

kernel_name = "hybrid_pool_stickbreak_memory_layer"


def rmsnorm(x, g):
    xf = x.astype(jnp.float32)
    y = xf * lax.rsqrt(jnp.mean(xf * xf, axis=-1, keepdims=True) + EPS)
    return (y * g.astype(jnp.float32)).astype(x.dtype)


def pool_mixer(u, pool_w, pool_scale):
    B, S, _ = u.shape
    uf = u.astype(jnp.float32).reshape(B, S, POOL_GROUPS, POOL_CH)
    csum = jnp.concatenate([jnp.zeros_like(uf[:, :1]), jnp.cumsum(uf, axis=1)], axis=1)
    t = jnp.arange(S)
    means = []
    for g, w in enumerate(POOL_WINDOWS):
        lo = jnp.maximum(t + 1 - w, 0)
        win_sum = csum[:, 1:, g] - csum[:, lo, g]
        count = (t + 1 - lo).astype(jnp.float32)
        means.append(win_sum / count[None, :, None])
    pooled = (jnp.stack(means, axis=2) - uf).astype(u.dtype)
    y = jnp.einsum('bsgc,gcd->bsgd', pooled, pool_w)
    return y.reshape(B, S, POOL_WIDTH) * pool_scale


def stick_breaking_attention(q, k, v):
    B, S, H, Dh = q.shape
    scale = Dh ** -0.5
    outs = []
    for i in range(S // Q_BLOCK):
        q0 = i * Q_BLOCK
        kv_len = q0 + Q_BLOCK
        qb = q[:, q0:kv_len]
        kb = k[:, :kv_len]
        vb = v[:, :kv_len]
        z = jnp.einsum('bqhd,bkhd->bhqk', qb, kb).astype(jnp.float32) * scale
        t_idx = q0 + jnp.arange(Q_BLOCK)
        s_idx = jnp.arange(kv_len)
        mask = s_idx[None, :] < t_idx[:, None]
        log_beta = jax.nn.log_sigmoid(z)
        log_1m_beta = jnp.where(mask, jax.nn.log_sigmoid(-z), 0.0)
        cum = jnp.cumsum(log_1m_beta, axis=-1)
        log_a = log_beta + cum[..., -1:] - cum
        a = jnp.where(mask, jnp.exp(log_a), 0.0)
        outs.append(jnp.einsum('bhqk,bkhd->bqhd', a.astype(v.dtype), vb))
    return jnp.concatenate(outs, axis=1)


def memory_attention(q, mem_k, mem_v, q_norm_g, k_norm_g):
    q = rmsnorm(q, q_norm_g)
    mem_k = rmsnorm(mem_k, k_norm_g)
    s = jnp.einsum('bqhd,bmhd->bhqm', q, mem_k).astype(jnp.float32) * (q.shape[-1] ** -0.5)
    p = jax.nn.softmax(s, axis=-1)
    return jnp.einsum('bhqm,bmhd->bqhd', p.astype(mem_v.dtype), mem_v)


def setup_inputs(seed: int = 0) -> dict:
    key = jax.random.key(seed)
    ks = jax.random.split(key, 12)
    f32 = jnp.float32
    x = jax.random.normal(ks[0], (BATCH, SEQ, D_MODEL), f32)
    mem = jax.random.normal(ks[1], (BATCH, MEM_LEN, D_MODEL), f32)
    norm_g = 1.0 + 0.02 * jax.random.normal(ks[2], (DEPTH, D_MODEL), f32)
    w_in = jax.random.normal(ks[3], (DEPTH, D_MODEL, IN_WIDTH), f32) * D_MODEL ** -0.5
    pool_w = jax.random.normal(ks[4], (DEPTH, POOL_GROUPS, POOL_CH, POOL_CH), f32) * POOL_CH ** -0.5
    pool_scale = 1.0 + 0.1 * jax.random.normal(ks[5], (DEPTH, POOL_WIDTH), f32)
    mem_norm_g = 1.0 + 0.02 * jax.random.normal(ks[6], (DEPTH, D_MODEL), f32)
    w_mem_kv = jax.random.normal(ks[7], (DEPTH, D_MODEL, 2 * MEM_WIDTH), f32) * D_MODEL ** -0.5
    q_norm_g = 1.0 + 0.02 * jax.random.normal(ks[8], (DEPTH, MEM_HEAD_DIM), f32)
    k_norm_g = 1.0 + 0.02 * jax.random.normal(ks[9], (DEPTH, MEM_HEAD_DIM), f32)
    w_out = jax.random.normal(ks[10], (DEPTH, MIX_WIDTH, D_MODEL), f32) * MIX_WIDTH ** -0.5
    return {"x": x, "mem": mem, "norm_g": norm_g, "w_in": w_in, "pool_w": pool_w,
            "pool_scale": pool_scale, "mem_norm_g": mem_norm_g, "w_mem_kv": w_mem_kv,
            "q_norm_g": q_norm_g, "k_norm_g": k_norm_g, "w_out": w_out}


def reference(x, mem, norm_g, w_in, pool_w, pool_scale, mem_norm_g, w_mem_kv, q_norm_g, k_norm_g, w_out):
    B, S, _ = x.shape
    M = mem.shape[1]
    split_points = list(np.cumsum(IN_SPLITS)[:-1])
    for l in range(DEPTH):
        h = rmsnorm(x, norm_g[l])
        proj = jnp.einsum('bsd,de->bse', h, w_in[l])
        (pool_v, pool_gate, sb_q, sb_k, sb_v, sb_gate,
         mem_q, mem_gate) = jnp.split(proj, split_points, axis=-1)

        y_pool = pool_mixer(pool_v, pool_w[l], pool_scale[l]) * jax.nn.silu(pool_gate)

        heads = lambda t: t.reshape(B, S, SB_HEADS, HEAD_DIM)
        y_sb = stick_breaking_attention(heads(sb_q), heads(sb_k), heads(sb_v)).reshape(B, S, SB_WIDTH)
        y_sb = y_sb * jax.nn.silu(sb_gate)

        mkv = jnp.einsum('bmd,de->bme', rmsnorm(mem, mem_norm_g[l]), w_mem_kv[l])
        mem_k, mem_v = jnp.split(mkv, 2, axis=-1)
        mem_k = mem_k.reshape(B, M, MEM_HEADS, MEM_HEAD_DIM)
        mem_v = mem_v.reshape(B, M, MEM_HEADS, MEM_HEAD_DIM)
        y_mem = memory_attention(mem_q.reshape(B, S, MEM_HEADS, MEM_HEAD_DIM), mem_k, mem_v,
                                 q_norm_g[l], k_norm_g[l]).reshape(B, S, MEM_WIDTH)
        y_mem = y_mem * jax.nn.silu(mem_gate)

        mixed = jnp.concatenate([y_pool, y_sb, y_mem], axis=-1)
        x = x + jnp.einsum('bse,ed->bsd', mixed, w_out[l])
    return x
```

```cpp
#include <hip/hip_runtime.h>
#include <cstdio>
#include <cstdint>
namespace pg8 {
#define PG8_LAS __attribute__((address_space(3)))
typedef unsigned short bf16_t;
typedef short bf16x8 __attribute__((ext_vector_type(8)));
typedef float f32x4 __attribute__((ext_vector_type(4)));
typedef unsigned u32x4 __attribute__((ext_vector_type(4)));
constexpr int BM = 256, BK = 64, HALF = 128, HTB = HALF * BK * 2  , STAGE_BYTES = 8 * HTB, NXCD = 8, WGM = 8;

__host__ __device__ __forceinline__ int lds_byte(int r, int c) { const int st = (r >> 4) * 2 + (c >> 5), rr = r & 15, cc = c & 31, ob = rr * 64 + cc * 2; return st * 1024 + (ob ^ (((ob >> 9) & 1) << 5)); }
__host__ __device__ __forceinline__ void stage_rc(int b, int& R, int& C) { const int st = b / 1024, sb = b % 1024, swz = sb ^ (((sb >> 9) & 1) << 5); R = (st >> 1) * 16 + swz / 64; C = (st & 1) * 32 + (swz % 64) / 2; }
__host__ __device__ __forceinline__ int perm32(int rho) { const int n = rho >> 4, i = rho & 15; return 8 * (i >> 2) + 4 * n + (i & 3); }

struct Unit { int pm, pn, kind; };
struct Gemm { const bf16_t* A; const bf16_t* Bt; int M, N, K, lda; const bf16_t* A2; const bf16_t* Bt2; };

struct StaticOrder {
    int nM, nN, nwg, G, c;
    __host__ __device__ void init(int M, int N, int G_, int c_) { nM = M / BM; nN = N / BM; nwg = nM * nN; G = G_; c = c_; }
    __host__ __device__ bool next(int i, Unit& u) const {
        const long L = (long)i * G + c; if (L >= nwg) return false;
        int wgid = (int)L; { const int q = nwg / NXCD, r = nwg % NXCD, xcd = wgid % NXCD, off = wgid / NXCD; wgid = (xcd < r ? xcd * (q + 1) : r * (q + 1) + (xcd - r) * q) + off; }
        const int nig = WGM * nN, gid = wgid / nig, fm = gid * WGM, gsz = (nM - fm) < WGM ? (nM - fm) : WGM;
        u.pm = fm + ((wgid % nig) % gsz); u.pn = (wgid % nig) / gsz; u.kind = 0; return true;
    }
    __device__ __forceinline__ void a_ready(const Unit&) const {}
    __device__ __forceinline__ void done(const Unit&) const {}
};

struct DualOrder {
    StaticOrder S0, S1; int n0, n1, G, c;
    __host__ __device__ void init(int M0, int N0, int M1, int N1, int G_, int c_) { S0.init(M0, N0, 1, 0); S1.init(M1, N1, 1, 0); n0 = S0.nwg; n1 = S1.nwg; G = G_; c = c_; }
    __host__ __device__ bool next(int i, Unit& u) const {
        const long L = (long)i * G + c; if (L >= n0 + n1) return false;
        if (L < n0) { S0.next((int)L, u); u.kind = 0; } else { S1.next((int)(L - n0), u); u.kind = 1; }
        return true;
    }
    __device__ __forceinline__ void a_ready(const Unit&) const {}
    __device__ __forceinline__ void done(const Unit&) const {}
};

__device__ __forceinline__ unsigned cvt_pk_bf16(float lo, float hi) { unsigned r; asm volatile("v_cvt_pk_bf16_f32 %0, %1, %2" : "=v"(r) : "v"(lo), "v"(hi)); return r; }
typedef float f32x2 __attribute__((ext_vector_type(2)));
struct EpiBf16S {
    static constexpr bool PERM = true, AFTER_DRAIN = false, PREFETCH = false;
    bf16_t* O; int ldc; int q_lo, q_hi; float scale;
    __device__ __forceinline__ void operator()(const f32x4 (&acc)[2][2][4][2], const Unit& u, int wr, int wc, int fr, int fq) const {
        const int row0 = u.pm * BM + wr * 64 + fr; const int col0 = u.pn * BM + wc * 32 + 8 * fq;
        const float sc = (u.pn >= q_lo && u.pn < q_hi) ? scale : 1.f;
#pragma unroll
        for (int ai = 0; ai < 2; ++ai)
#pragma unroll
            for (int m = 0; m < 4; ++m) { bf16_t* rowp = O + (size_t)(row0 + ai * HALF + m * 16) * ldc + col0;
#pragma unroll
                for (int bj = 0; bj < 2; ++bj) { f32x4 v0 = acc[ai][bj][m][0] * sc, v1 = acc[ai][bj][m][1] * sc;
                    u32x4 w; w.x = cvt_pk_bf16(v0[0], v0[1]); w.y = cvt_pk_bf16(v0[2], v0[3]); w.z = cvt_pk_bf16(v1[0], v1[1]); w.w = cvt_pk_bf16(v1[2], v1[3]);
                    *(u32x4*)(rowp + bj * HALF) = w; } }
    }
};
struct EpiResF32 {
    static constexpr bool PERM = false, AFTER_DRAIN = false, PREFETCH = true;
    const float* base; float* out; int ldc; PG8_LAS unsigned char* pf;
    __device__ __forceinline__ void prefetch(const Unit& u, int wr, int wc, int fr, int fq, int wid, int slot) const {
        const int s = 31 - (slot & 31);
        const float* p = base + (size_t)(u.pm * BM + (s >> 4) * HALF + wr * 64 + ((s >> 2) & 3) * 16 + fr) * ldc + u.pn * BM + wc * 32 + 4 * fq + ((s >> 1) & 1) * HALF + (s & 1) * 16;
        __builtin_amdgcn_global_load_lds((const unsigned*)p, (PG8_LAS unsigned*)(pf + wid * 1024), 16, 0, 0);
    }
    __device__ __forceinline__ void operator()(const f32x4 (&acc)[2][2][4][2], const Unit& u, int wr, int wc, int fr, int fq) const {
        const float* __restrict__ bp = base; float* __restrict__ op = out;
        const int col0 = u.pn * BM + wc * 32 + 4 * fq;
#pragma unroll
        for (int ai = 0; ai < 2; ++ai) {
            f32x4 xv[4][2][2];
#pragma unroll
            for (int m = 0; m < 4; ++m) { const size_t off = (size_t)(u.pm * BM + ai * HALF + wr * 64 + m * 16 + fr) * ldc + col0;
#pragma unroll
                for (int bj = 0; bj < 2; ++bj)
#pragma unroll
                    for (int n = 0; n < 2; ++n) xv[m][bj][n] = *(const f32x4*)(bp + off + bj * HALF + n * 16); }
#pragma unroll
            for (int m = 0; m < 4; ++m) { const size_t off = (size_t)(u.pm * BM + ai * HALF + wr * 64 + m * 16 + fr) * ldc + col0;
#pragma unroll
                for (int bj = 0; bj < 2; ++bj)
#pragma unroll
                    for (int n = 0; n < 2; ++n) *(f32x4*)(op + off + bj * HALF + n * 16) = xv[m][bj][n] + acc[ai][bj][m][n]; }
        }
    }
};
struct EpiImg {
    static constexpr bool PERM = true, AFTER_DRAIN = false, PREFETCH = false;
    bf16_t* IMG; float scale;
    __device__ __forceinline__ void operator()(const f32x4 (&acc)[2][2][4][2], const Unit& u, int wr, int wc, int fr, int fq) const {
        const int row0 = u.pm * BM + wr * 64 + fr;
        const int pn = u.pn;
        const bool isO = (pn == 1 || pn == 6 || pn == 7 || pn == 9), isK = (pn == 4 || pn == 5);
        const float sc = (pn == 2 || pn == 3) ? scale : 1.f;
        const int c = (wc & 1) * 4 + fq;
        const int f = isO ? 2 * (c >> 2) + (c & 1) : (c >> 1), hs = isO ? (c >> 1) & 1 : (c & 1);
#pragma unroll
        for (int ai = 0; ai < 2; ++ai)
#pragma unroll
            for (int m = 0; m < 4; ++m) { const int row = row0 + ai * HALF + m * 16;
                const int b = row >> 11, t = row & 2047, tl = t & 31, rp = isK ? ((tl & 0x13) | ((tl & 4) << 1) | ((tl & 8) >> 1)) : tl;
#pragma unroll
                for (int bj = 0; bj < 2; ++bj) { f32x4 v0 = acc[ai][bj][m][0] * sc, v1 = acc[ai][bj][m][1] * sc;
                    u32x4 w; w.x = cvt_pk_bf16(v0[0], v0[1]); w.y = cvt_pk_bf16(v0[2], v0[3]); w.z = cvt_pk_bf16(v1[0], v1[1]); w.w = cvt_pk_bf16(v1[2], v1[3]);
                    const int cg = (pn * BM + bj * HALF + wc * 32) >> 6;
                    *(u32x4*)(IMG + ((((size_t)(cg * 8 + b) * 64 + (t >> 5)) * 4 + f) * 64 + hs * 32 + rp) * 8) = w; } }
    }
};
struct EpiVblk {
    static constexpr bool PERM = true, AFTER_DRAIN = false, PREFETCH = false;
    bf16_t* VB;
    __device__ __forceinline__ void operator()(const f32x4 (&acc)[2][2][4][2], const Unit& u, int wr, int wc, int fr, int fq) const {
        const int row0 = u.pm * BM + wr * 64 + fr; const int col0 = u.pn * BM + wc * 32 + 8 * fq;
#pragma unroll
        for (int ai = 0; ai < 2; ++ai)
#pragma unroll
            for (int m = 0; m < 4; ++m) { const int row = row0 + ai * HALF + m * 16; const int h = row >> 6, d = row & 63, dh = d >> 5, x = d & 31, si = (((x >> 2) & 3) << 3) | (((x >> 4) & 1) << 2) | (x & 3);
#pragma unroll
                for (int bj = 0; bj < 2; ++bj) { const f32x4 v0 = acc[ai][bj][m][0], v1 = acc[ai][bj][m][1];
                    u32x4 w; w.x = cvt_pk_bf16(v0[0], v0[1]); w.y = cvt_pk_bf16(v0[2], v0[3]); w.z = cvt_pk_bf16(v1[0], v1[1]); w.w = cvt_pk_bf16(v1[2], v1[3]);
                    const int n = col0 + bj * HALF, b = n >> 11, key = n & 2047;
                    *(u32x4*)(VB + ((((size_t)(b * 8 + h) * 128 + (key >> 4)) * 2 + dh) * 64 + ((key >> 3) & 1) * 32 + si) * 8) = w; } }
    }
};
struct EpiProjAll {
    static constexpr bool PERM = true, AFTER_DRAIN = false, PREFETCH = false;
    EpiImg img; EpiVblk vb;
    __device__ __forceinline__ void operator()(const f32x4 (&acc)[2][2][4][2], const Unit& u, int wr, int wc, int fr, int fq) const {
        if (u.kind) vb(acc, u, wr, wc, fr, fq); else img(acc, u, wr, wc, fr, fq);
    }
};
template <class Epi, class Sched, bool ALIGN_EPI = false, bool SP2 = false>
__device__ __forceinline__ void gemm_phase(PG8_LAS unsigned char* lds, const Gemm g, const Sched& S, const Epi& E) {
    int tid_ = threadIdx.x; asm volatile("" : "+v"(tid_));
    const int tid = tid_, wid = __builtin_amdgcn_readfirstlane(tid >> 6), lane = tid & 63, wr = wid >> 2, wc = wid & 3, fr = lane & 15, fq = lane >> 4;
    const int K = g.K, nt = K / BK;
    unsigned voffA[2], voffB[2];
#pragma unroll
    for (int i = 0; i < 2; ++i) { int R, C; stage_rc(tid * 16 + i * 8192, R, C); const int Rb = Epi::PERM ? ((R & ~31) + perm32(R & 31)) : R;
        voffA[i] = (unsigned)(R * g.lda + C) * 2u; voffB[i] = (unsigned)(Rb * K + C) * 2u; }
    const size_t kstep = (size_t)(BK * 2);
    const size_t hstep = (size_t)HALF * K * 2;
    const size_t tstep = 2 * hstep;
    const size_t hstepA = (size_t)HALF * g.lda * 2, tstepA = 2 * hstepA;
    const unsigned ldsw = (unsigned)wid * 1024u;
    const int aoff = lds_byte(wr * 64 + fr, fq * 8), boff = lds_byte(wc * 32 + fr, fq * 8);
#define PG8_SA(b, h) (((b) * 2 + (h)) * HTB)
#define PG8_SB(b, h) ((4 + (b) * 2 + (h)) * HTB)
#define PG8_STAGE(bufoff, gbase, voff) do { _Pragma("unroll") for (int _i = 0; _i < 2; ++_i) \
        __builtin_amdgcn_global_load_lds((const unsigned*)((const char*)(gbase) + (voff)[_i]), (PG8_LAS unsigned*)(lds + (bufoff) + ldsw + _i * 8192), 16, 0, 0); } while (0)
#define PG8_LDA(dst, b, h) do { _Pragma("unroll") for (int m = 0; m < 4; ++m) _Pragma("unroll") for (int k = 0; k < 2; ++k) dst[m][k] = *(const PG8_LAS bf16x8*)(lds + PG8_SA(b, h) + aoff + m * 2048 + k * 1024); } while (0)
#define PG8_LDB(dst, b, h) do { _Pragma("unroll") for (int n = 0; n < 2; ++n) _Pragma("unroll") for (int k = 0; k < 2; ++k) dst[n][k] = *(const PG8_LAS bf16x8*)(lds + PG8_SB(b, h) + boff + n * 2048 + k * 1024); } while (0)
#define PG8_MMA(ai, bj, At, Bt) do { __builtin_amdgcn_s_setprio(1); _Pragma("unroll") for (int m = 0; m < 4; ++m) _Pragma("unroll") for (int n = 0; n < 2; ++n) _Pragma("unroll") for (int k = 0; k < 2; ++k) \
        acc[ai][bj][m][n] = __builtin_amdgcn_mfma_f32_16x16x32_bf16(Bt[n][k], At[m][k], acc[ai][bj][m][n], 0, 0, 0); __builtin_amdgcn_s_setprio(0); } while (0)
#define PG8_WAIT_V(n) asm volatile("s_waitcnt vmcnt(" #n ")" ::: "memory")
#define PG8_WAIT_VP do { if constexpr (Epi::PREFETCH) asm volatile("s_waitcnt vmcnt(9)" ::: "memory"); else asm volatile("s_waitcnt vmcnt(8)" ::: "memory"); } while (0)
#define PG8_PF(j) do { if constexpr (Epi::PREFETCH) E.prefetch(cur, wr, wc, fr, fq, wid, (t >> 1) * 4 + (j)); } while (0)
#define PG8_WAIT_L(n) asm volatile("s_waitcnt lgkmcnt(" #n ")" ::: "memory")
#define PG8_BAR __builtin_amdgcn_s_barrier()
#define PG8_SCHED __builtin_amdgcn_sched_barrier(0)
    Unit cur, nxt; int ui = 0;
    if (!S.next(0, cur)) return;
    f32x4 acc[2][2][4][2];
#pragma unroll
    for (int a = 0; a < 2; ++a)
#pragma unroll
        for (int b = 0; b < 2; ++b)
#pragma unroll
            for (int m = 0; m < 4; ++m)
#pragma unroll
                for (int n = 0; n < 2; ++n) acc[a][b][m][n] = (f32x4){0.f, 0.f, 0.f, 0.f};
    bf16x8 At[4][2], B0[2][2], B1[2][2];
    const char* cA = (const char*)(cur.kind ? g.A2 : g.A) + (size_t)cur.pm * tstepA; const char* cB = (const char*)(cur.kind ? g.Bt2 : g.Bt) + (size_t)cur.pn * tstep;
    S.a_ready(cur);
    if constexpr (SP2) {
        PG8_STAGE(PG8_SB(0, 0), cB, voffB); PG8_STAGE(PG8_SB(0, 1), cB + hstep, voffB); PG8_STAGE(PG8_SA(0, 0), cA, voffA); PG8_STAGE(PG8_SA(0, 1), cA + hstepA, voffA);
        if (wr == 1) PG8_BAR;
        PG8_WAIT_V(2); PG8_BAR;
        PG8_STAGE(PG8_SB(1, 0), cB + kstep, voffB); PG8_STAGE(PG8_SA(1, 0), cA + kstep, voffA); PG8_STAGE(PG8_SB(1, 1), cB + hstep + kstep, voffB);
        PG8_WAIT_V(6); PG8_BAR;
    } else {
        PG8_STAGE(PG8_SB(0, 0), cB, voffB); PG8_STAGE(PG8_SA(0, 0), cA, voffA); PG8_STAGE(PG8_SB(0, 1), cB + hstep, voffB); PG8_STAGE(PG8_SA(0, 1), cA + hstepA, voffA);
        if (wr == 1) PG8_BAR;
        PG8_WAIT_V(4); PG8_BAR;
        PG8_STAGE(PG8_SB(1, 0), cB + kstep, voffB); PG8_STAGE(PG8_SA(1, 0), cA + kstep, voffA); PG8_STAGE(PG8_SB(1, 1), cB + hstep + kstep, voffB);
        PG8_WAIT_V(6); PG8_BAR;
    }
    for (;;) {
        const bool has_next = S.next(ui + 1, nxt);
        const char* nA = has_next ? (const char*)(nxt.kind ? g.A2 : g.A) + (size_t)nxt.pm * tstepA : cA; const char* nB = has_next ? (const char*)(nxt.kind ? g.Bt2 : g.Bt) + (size_t)nxt.pn * tstep : cB;
        for (int t = 0; t < nt; t += 2) {
            const bool last = (t == nt - 2);
            const char* a1 = cA + (size_t)(t + 1) * kstep;
            const char* a2 = last ? nA : cA + (size_t)(t + 2) * kstep; const char* b2 = last ? nB : cB + (size_t)(t + 2) * kstep;
            const char* a3 = a2 + kstep; const char* b3 = b2 + kstep;
            if (last && has_next) S.a_ready(nxt);
            if constexpr (SP2) {
            PG8_LDB(B0, 0, 0); PG8_LDB(B1, 0, 1); PG8_SCHED; PG8_LDA(At, 0, 0); PG8_PF(0); PG8_STAGE(PG8_SA(1, 1), a1 + hstepA, voffA);
            PG8_WAIT_VP; PG8_WAIT_L(0); PG8_BAR; PG8_MMA(0, 0, At, B0); PG8_MMA(0, 1, At, B1); PG8_BAR; PG8_SCHED;
            PG8_LDA(At, 0, 1); PG8_PF(1); PG8_STAGE(PG8_SB(0, 0), b2, voffB); PG8_STAGE(PG8_SB(0, 1), b2 + hstep, voffB); PG8_STAGE(PG8_SA(0, 0), a2, voffA);
            PG8_WAIT_VP; PG8_WAIT_L(0); PG8_BAR; PG8_MMA(1, 0, At, B0); PG8_MMA(1, 1, At, B1); PG8_BAR; PG8_SCHED;
            PG8_LDB(B0, 1, 0); PG8_LDB(B1, 1, 1); PG8_SCHED; PG8_LDA(At, 1, 0); PG8_PF(2); PG8_STAGE(PG8_SA(0, 1), a2 + hstepA, voffA);
            PG8_WAIT_VP; PG8_WAIT_L(0); PG8_BAR; PG8_MMA(0, 0, At, B0); PG8_MMA(0, 1, At, B1); PG8_BAR; PG8_SCHED;
            PG8_LDA(At, 1, 1); PG8_PF(3); PG8_STAGE(PG8_SB(1, 0), b3, voffB); PG8_STAGE(PG8_SB(1, 1), b3 + hstep, voffB); PG8_STAGE(PG8_SA(1, 0), a3, voffA);
            PG8_WAIT_VP; PG8_WAIT_L(0); PG8_BAR; PG8_MMA(1, 0, At, B0); PG8_MMA(1, 1, At, B1); PG8_BAR; PG8_SCHED;
            } else {
            PG8_LDB(B0, 0, 0); PG8_SCHED; PG8_LDA(At, 0, 0); PG8_STAGE(PG8_SA(1, 1), a1 + hstepA, voffA);
            PG8_WAIT_L(8); PG8_BAR; PG8_WAIT_L(0); PG8_MMA(0, 0, At, B0); PG8_BAR; PG8_SCHED;
            PG8_LDB(B1, 0, 1); PG8_STAGE(PG8_SB(0, 0), b2, voffB);
            PG8_BAR; PG8_WAIT_L(0); PG8_MMA(0, 1, At, B1); PG8_BAR;
            PG8_LDA(At, 0, 1); PG8_STAGE(PG8_SA(0, 0), a2, voffA);
            PG8_BAR; PG8_WAIT_L(0); PG8_MMA(1, 0, At, B0); PG8_BAR; PG8_SCHED;
            PG8_STAGE(PG8_SB(0, 1), b2 + hstep, voffB);
            PG8_WAIT_V(6); PG8_BAR; PG8_MMA(1, 1, At, B1); PG8_BAR;
            PG8_LDB(B0, 1, 0); PG8_SCHED; PG8_LDA(At, 1, 0); PG8_STAGE(PG8_SA(0, 1), a2 + hstepA, voffA);
            PG8_WAIT_L(8); PG8_BAR; PG8_WAIT_L(0); PG8_MMA(0, 0, At, B0); PG8_BAR; PG8_SCHED;
            PG8_LDB(B1, 1, 1); PG8_STAGE(PG8_SB(1, 0), b3, voffB);
            PG8_BAR; PG8_WAIT_L(0); PG8_MMA(0, 1, At, B1); PG8_BAR;
            PG8_LDA(At, 1, 1); PG8_STAGE(PG8_SA(1, 0), a3, voffA);
            PG8_BAR; PG8_WAIT_L(0); PG8_MMA(1, 0, At, B0); PG8_BAR; PG8_SCHED;
            PG8_STAGE(PG8_SB(1, 1), b3 + hstep, voffB);
            PG8_WAIT_V(6); PG8_BAR; PG8_MMA(1, 1, At, B1); PG8_BAR;
            }
        }
        if constexpr (ALIGN_EPI) { if (wr == 0) PG8_BAR; }
        if constexpr (!Epi::AFTER_DRAIN) { E(acc, cur, wr, wc, fr, fq); S.done(cur); }
        if (!has_next) break;
#pragma unroll
        for (int a = 0; a < 2; ++a)
#pragma unroll
            for (int b = 0; b < 2; ++b)
#pragma unroll
                for (int m = 0; m < 4; ++m)
#pragma unroll
                    for (int n = 0; n < 2; ++n) acc[a][b][m][n] = (f32x4){0.f, 0.f, 0.f, 0.f};
        cur = nxt; cA = nA; cB = nB; ++ui;
        if constexpr (ALIGN_EPI) { if (wr == 1) PG8_BAR; }
    }
    PG8_WAIT_V(0);
    if constexpr (!ALIGN_EPI) { if (wr == 0) PG8_BAR; }
    PG8_BAR;
    if constexpr (Epi::AFTER_DRAIN) { E.fused(acc, cur, wr, wc, fr, fq, lds, wid, lane); S.done(cur); }
#undef PG8_SA
#undef PG8_SB
#undef PG8_STAGE
#undef PG8_LDA
#undef PG8_LDB
#undef PG8_MMA
#undef PG8_WAIT_V
#undef PG8_WAIT_L
#undef PG8_WAIT_VP
#undef PG8_PF
#undef PG8_BAR
#undef PG8_SCHED
}
}
constexpr int BATCH = 8, SEQ = 2048, DM = 1024, MTOK = BATCH * SEQ;
constexpr int MEM_LEN = 256, MROWS = BATCH * MEM_LEN;
constexpr int IN_WIDTH = 3072;
constexpr int PITCH = 2560;
constexpr int COL_PV = 0, COL_PG = 256, COL_Q = 512, COL_K = 1024, COL_SG = 1536, COL_MQ = 2048, COL_MG = 2304;
constexpr int MIX_POOL = 0, MIX_SB = 256, MIX_MEM = 768;
constexpr int MIXP = 1088;
constexpr int CG_PV = 0, CG_PG = 4, CG_Q = 8, CG_K = 16, CG_SG = 24, CG_MQ = 32, CG_MG = 36;
constexpr size_t IMG_TILE = 4 * 512, IMG_B = 64 * IMG_TILE, IMG_CG = 8 * IMG_B;
constexpr float EPS = 1e-6f;
constexpr float LOG2E = 1.4426950408889634f;
constexpr float C2 = 0.125f * LOG2E;
#ifndef SB_EARLY_EXIT
#define SB_EARLY_EXIT 1
#endif
constexpr size_t MiB = 1u << 20;
constexpr size_t WS_WIN = 0, WS_WV = 5 * MiB, WS_WOUT = 6 * MiB, WS_WKV = 8 * MiB, WS_MN = 9 * MiB, WS_KM = 13 * MiB, WS_VMT = 14 * MiB, WS_PWT = 15 * MiB, WS_CTL = 15 * MiB + 512 * 1024,
                 WS_VT = 16 * MiB, WS_MIXED = 32 * MiB, WS_PROJ = 68 * MiB, WS_XN = 148 * MiB, WS_END = 180 * MiB;
constexpr size_t CTL_BYTES = 16384;
constexpr int LDS_BYTES = 131072 + 1024 + 8192;

#define LAS __attribute__((address_space(3)))
typedef unsigned short bf16;
typedef short bf16x8 __attribute__((ext_vector_type(8)));
typedef float f32x4 __attribute__((ext_vector_type(4)));
typedef float f32x16 __attribute__((ext_vector_type(16)));
typedef unsigned v4u __attribute__((ext_vector_type(4)));
typedef unsigned v2u __attribute__((ext_vector_type(2)));
typedef float f32x2_t __attribute__((ext_vector_type(2))); typedef __bf16 bf16x2_t __attribute__((ext_vector_type(2)));
#define DI __device__ __forceinline__
#define MFMA32(a, b, c) __builtin_amdgcn_mfma_f32_32x32x16_bf16((a), (b), (c), 0, 0, 0)
DI unsigned cvtpk(float lo, float hi) { f32x2_t v = {lo, hi}; bf16x2_t b = __builtin_convertvector(v, bf16x2_t); return __builtin_bit_cast(unsigned, b); }
DI float bflo(unsigned w) { return __uint_as_float(w << 16); }
DI float bfhi(unsigned w) { return __uint_as_float(w & 0xffff0000u); }
DI bf16x8 ld8(const bf16* p) { return *(const bf16x8*)p; }
DI float ex2(float x) { return __builtin_amdgcn_exp2f(x); }
DI float lg2(float x) { return __builtin_amdgcn_logf(x); }
DI float silu(float g) { return g * __builtin_amdgcn_rcpf(1.f + ex2(-g * LOG2E)); }
DI int pi_perm(int i) { return (i & 0x13) | ((i & 4) << 1) | ((i & 8) >> 1); }
DI int sigma_perm(int i) { return ((i >> 2) & 1) * 16 + (i >> 3) * 4 + (i & 3); }
DI float xhalf_sum(float v) { auto rr = __builtin_amdgcn_permlane32_swap(__float_as_uint(v), __float_as_uint(v), false, false); return __uint_as_float(rr[0]) + __uint_as_float(rr[1]); }
DI float xhalf_max(float v) { auto rr = __builtin_amdgcn_permlane32_swap(__float_as_uint(v), __float_as_uint(v), false, false); return fmaxf(__uint_as_float(rr[0]), __uint_as_float(rr[1])); }
DI float wave_sum(float v) {
#pragma unroll
    for (int o = 1; o < 64; o <<= 1) v += __shfl_xor(v, o);
    return v;
}
DI unsigned f2bf(float f) { unsigned u = __builtin_bit_cast(unsigned, f); return (u + 0x7fffu + ((u >> 16) & 1u)) >> 16; }
DI unsigned pk2(float lo, float hi) { return f2bf(lo) | (f2bf(hi) << 16); }

DI void p0_transpose_item(const float* W, int K, int N, bf16* WT, int row_off, LAS float* scr, int item, int lane, int img = 0) {
    const int nblk = N / 64, kb = item / nblk, nb = item % nblk, k0 = 32 * kb, n0 = 64 * nb;
    float t[32];
#pragma unroll
    for (int i = 0; i < 32; ++i) t[i] = W[(size_t)(k0 + i) * N + n0 + lane];
#pragma unroll
    for (int i = 0; i < 32; ++i) scr[i * 65 + lane] = t[i];
    asm volatile("s_waitcnt lgkmcnt(0)" ::: "memory");
    const int c = lane & 3;
#pragma unroll
    for (int j = 0; j < 4; ++j) { const int n = (lane >> 2) + 16 * j; const LAS float* s = scr + (8 * c) * 65 + n;
        v4u o; o.x = pk2(s[0 * 65], s[1 * 65]); o.y = pk2(s[2 * 65], s[3 * 65]); o.z = pk2(s[4 * 65], s[5 * 65]); o.w = pk2(s[6 * 65], s[7 * 65]);
        const int ng = row_off + n0 + n, kk = k0 + 8 * c;
        bf16* dst = img ? WT + ((size_t)(((ng >> 5) * (K >> 4) + (kk >> 4)) * 64 + ((kk >> 3) & 1) * 32 + (ng & 31))) * 8 : WT + (size_t)ng * K + kk;
        *(v4u*)dst = o; }
    asm volatile("s_waitcnt lgkmcnt(0)" ::: "memory");
}
template <int NR>
DI void rms_rows_to_bf16(const float* x, const float* g, bf16* out, int m0, int step, int mend, int lane) {
    f32x4 v[NR][4];
#pragma unroll
    for (int n = 0; n < NR; ++n) { const int m = (m0 + n * step < mend) ? m0 + n * step : m0; const f32x4* xr = (const f32x4*)(x + (size_t)m * DM) + lane;
#pragma unroll
        for (int j = 0; j < 4; ++j) v[n][j] = xr[64 * j]; }
    f32x4 gg[4];
#pragma unroll
    for (int j = 0; j < 4; ++j) gg[j] = ((const f32x4*)g + lane)[64 * j];
#pragma unroll
    for (int n = 0; n < NR; ++n) { float s = 0.f;
#pragma unroll
        for (int j = 0; j < 4; ++j) s += (v[n][j].x * v[n][j].x + v[n][j].y * v[n][j].y) + (v[n][j].z * v[n][j].z + v[n][j].w * v[n][j].w);
        const float r = __builtin_amdgcn_rsqf(wave_sum(s) * (1.f / DM) + EPS);
        const int m = m0 + n * step;
        if (m < mend) { unsigned long long* o8 = (unsigned long long*)(out + (size_t)m * DM) + lane;
#pragma unroll
            for (int j = 0; j < 4; ++j) o8[64 * j] = (unsigned long long)cvtpk(v[n][j].x * r * gg[j].x, v[n][j].y * r * gg[j].y) | ((unsigned long long)cvtpk(v[n][j].z * r * gg[j].z, v[n][j].w * r * gg[j].w) << 32); } }
}

DI void rms_row_to_img(const float* __restrict__ x, const float* __restrict__ g, bf16* __restrict__ MNI, int m, int lane) {
    const f32x4* xr = (const f32x4*)(x + (size_t)m * DM) + lane; const f32x4* gr = (const f32x4*)g + lane;
    f32x4 v[4]; float s = 0.f;
#pragma unroll
    for (int j = 0; j < 4; ++j) { v[j] = xr[64 * j]; s += (v[j].x * v[j].x + v[j].y * v[j].y) + (v[j].z * v[j].z + v[j].w * v[j].w); }
    const float r = __builtin_amdgcn_rsqf(wave_sum(s) * (1.f / DM) + EPS);
    const int rt = m >> 5, rl = m & 31;
#pragma unroll
    for (int j = 0; j < 4; ++j) { const f32x4 gg = gr[64 * j]; const int ks = (lane >> 2) + 16 * j;
        unsigned long long* o8 = (unsigned long long*)(MNI + ((size_t)((rt * 64 + ks) * 64 + ((lane >> 1) & 1) * 32 + rl)) * 8 + (lane & 1) * 4);
        *o8 = (unsigned long long)cvtpk(v[j].x * r * gg.x, v[j].y * r * gg.y) | ((unsigned long long)cvtpk(v[j].z * r * gg.z, v[j].w * r * gg.w) << 32); }
}

DI void memkv_partial(const bf16* __restrict__ MNI, const bf16* __restrict__ WKI, int tile, int kq, int lane, f32x16& a0, f32x16& a1) {
    const int r32 = lane & 31, hi = lane >> 5;
    const bool isV = tile >= 256; const int tt = tile & 255, rt = tt >> 2, hd = tt & 3;
    const int nt0 = ((isV ? 256 : 0) + hd * 64) >> 5;
    const int pslot = hi * 32 + sigma_perm(r32);
    if (!isV) {
        const bf16* wp0 = WKI + ((size_t)((nt0 * 64 + kq * 16) * 64 + pslot)) * 8; const bf16* wp1 = wp0 + (size_t)64 * 512;
        const bf16* mp = MNI + ((size_t)((rt * 64 + kq * 16) * 64 + lane)) * 8;
#pragma unroll
        for (int ks = 0; ks < 16; ++ks) { const bf16x8 bm = ld8(mp + ks * 512); a0 = MFMA32(ld8(wp0 + ks * 512), bm, a0); a1 = MFMA32(ld8(wp1 + ks * 512), bm, a1); }
    } else {
        const bf16* mp = MNI + ((size_t)((rt * 64 + kq * 16) * 64 + pslot)) * 8;
        const bf16* wp0 = WKI + ((size_t)((nt0 * 64 + kq * 16) * 64 + lane)) * 8; const bf16* wp1 = wp0 + (size_t)64 * 512;
#pragma unroll
        for (int ks = 0; ks < 16; ++ks) { const bf16x8 am = ld8(mp + ks * 512); a0 = MFMA32(am, ld8(wp0 + ks * 512), a0); a1 = MFMA32(am, ld8(wp1 + ks * 512), a1); }
    }
}
DI void memkv_epilogue(const float* __restrict__ kng, bf16* __restrict__ KM, bf16* __restrict__ VMT, int tile, int lane, const f32x16& a0, const f32x16& a1) {
    const int r32 = lane & 31, hi = lane >> 5;
    const bool isV = tile >= 256; const int tt = tile & 255, rt = tt >> 2, hd = tt & 3;
    if (!isV) {
        float ss = 0.f;
#pragma unroll
        for (int r = 0; r < 16; ++r) ss += a0[r] * a0[r] + a1[r] * a1[r];
        ss = xhalf_sum(ss);
        const float rs = __builtin_amdgcn_rsqf(ss * (1.f / 64.f) + EPS);
        bf16* op = KM + (((size_t)((rt >> 3) * 4 + hd) * 8 + (rt & 7)) * 4 + hi) * 512 + pi_perm(r32) * 8;
#pragma unroll
        for (int cb = 0; cb < 2; ++cb) { const f32x16& a = cb ? a1 : a0; const float* gp = kng + cb * 32 + hi * 16;
            v4u w0, w1;
            w0.x = cvtpk(a[0] * rs * gp[0], a[1] * rs * gp[1]); w0.y = cvtpk(a[2] * rs * gp[2], a[3] * rs * gp[3]); w0.z = cvtpk(a[4] * rs * gp[4], a[5] * rs * gp[5]); w0.w = cvtpk(a[6] * rs * gp[6], a[7] * rs * gp[7]);
            w1.x = cvtpk(a[8] * rs * gp[8], a[9] * rs * gp[9]); w1.y = cvtpk(a[10] * rs * gp[10], a[11] * rs * gp[11]); w1.z = cvtpk(a[12] * rs * gp[12], a[13] * rs * gp[13]); w1.w = cvtpk(a[14] * rs * gp[14], a[15] * rs * gp[15]);
            *(v4u*)(op + cb * 2 * 512) = w0; *(v4u*)(op + cb * 2 * 512 + 256) = w1; }
    } else {
        const int b = rt >> 3, m0 = (rt & 7) * 32 + hi * 16;
#pragma unroll
        for (int cb = 0; cb < 2; ++cb) { const f32x16& a = cb ? a1 : a0;
            const int si = (((r32 >> 2) & 3) << 3) | (((r32 >> 4) & 1) << 2) | (r32 & 3);
            bf16* op = VMT + ((((size_t)(b * 4 + hd) * 16 + (m0 >> 4)) * 2 + cb) * 64 + si) * 8;
            v4u w0, w1;
            w0.x = cvtpk(a[0], a[1]); w0.y = cvtpk(a[2], a[3]); w0.z = cvtpk(a[4], a[5]); w0.w = cvtpk(a[6], a[7]);
            w1.x = cvtpk(a[8], a[9]); w1.y = cvtpk(a[10], a[11]); w1.z = cvtpk(a[12], a[13]); w1.w = cvtpk(a[14], a[15]);
            *(v4u*)(op) = w0; *(v4u*)(op + 256) = w1; }
    }
}
#define XB_TMO      128
#define XB_XCNT(j)  (256  + 64 * (j))
#define XB_XSUB(j)  (1280 + 64 * (j))
#define XB_XGEN(j)  (2304 + 64 * (j))
#define XB_TOP      3328
#define XB_TOPGEN   3392
#define XCD_BAR_WORDS 3456
#define XB_BARRIERS_PER_LAUNCH 1u
#define XB_SPIN_CAP (1u << 18)

__device__ __forceinline__ unsigned xb_ld(unsigned* p)              { return __hip_atomic_load(p, __ATOMIC_RELAXED, __HIP_MEMORY_SCOPE_AGENT); }
__device__ __forceinline__ unsigned xb_add(unsigned* p, unsigned v) { return __hip_atomic_fetch_add(p, v, __ATOMIC_RELAXED, __HIP_MEMORY_SCOPE_AGENT); }
__device__ __forceinline__ unsigned xb_xcc_id() { return (unsigned)__builtin_amdgcn_s_getreg((3 << 11) | 20) & 0xFu; }
#define XB_SPIN(cond, bar) do { unsigned _sp = 0; while (cond) { __builtin_amdgcn_s_sleep(1); \
    if ((++_sp & 255u) == 0u) { if (xb_ld(&(bar)[XB_TMO])) break; if (_sp > XB_SPIN_CAP) { atomicAdd(&(bar)[XB_TMO], 1u); break; } } } } while (0)

struct XcdBarrier {
    unsigned* bar; unsigned x; unsigned calls;
    volatile LAS unsigned* st;
};

__device__ __forceinline__ XcdBarrier xcd_barrier_post(unsigned* bar, volatile LAS unsigned* st) {
    XcdBarrier b; b.bar = bar; b.x = xb_xcc_id(); b.st = st;
    b.calls = xb_ld(&bar[XB_TOPGEN]) / XB_BARRIERS_PER_LAUNCH;
    if (threadIdx.x == 0) (void)xb_add(&bar[XB_XCNT(b.x)], 1u);
    return b;
}
__device__ __forceinline__ void xcd_barrier_complete(unsigned* bar, unsigned x, unsigned calls, unsigned& nloc, unsigned& nx) {
    const unsigned G = gridDim.x * gridDim.y * gridDim.z * (calls + 1u);
    unsigned sum, cnt, mine, sp = 0u;
    for (;;) {
        sum = 0u; cnt = 0u; mine = 0u;
#pragma unroll
        for (unsigned j = 0; j < 16; ++j) { const unsigned c = xb_ld(&bar[XB_XCNT(j)]); sum += c; cnt += (c > 0u) ? 1u : 0u; mine = (j == x) ? c : mine; }
        if (sum == G) break;
        __builtin_amdgcn_s_sleep(1);
        if ((++sp & 255u) == 0u) { if (xb_ld(&bar[XB_TMO])) break; if (sp > XB_SPIN_CAP) { atomicAdd(&bar[XB_TMO], 1u); break; } }
    }
    mine /= (calls + 1u); nloc = mine > 0u ? mine : 1u; nx = cnt > 0u ? cnt : 1u;
}

__device__ __forceinline__ void xcd_barrier(const XcdBarrier& b) {
    asm volatile("s_waitcnt vmcnt(0)" ::: "memory");
    __syncthreads();
    if (threadIdx.x == 0) {
        unsigned* bar = b.bar;
        __builtin_amdgcn_s_waitcnt(0);
        unsigned nloc = b.st[0], nx = b.st[1];
        if (nloc == 0u) { xcd_barrier_complete(bar, b.x, b.calls, nloc, nx); b.st[0] = nloc; b.st[1] = nx; }
        const unsigned old = xb_add(&bar[XB_XSUB(b.x)], 1u);
        const unsigned gen = old / nloc;
        if (old + 1u == (gen + 1u) * nloc) {
            __builtin_amdgcn_fence(__ATOMIC_RELEASE, "agent");
            asm volatile("s_waitcnt vmcnt(0)" ::: "memory");
            const unsigned og = xb_add(&bar[XB_TOP], 1u);
            const unsigned tg = og / nx;
            if (og + 1u == (tg + 1u) * nx) xb_add(&bar[XB_TOPGEN], 1u);
            else XB_SPIN(xb_ld(&bar[XB_TOPGEN]) == tg, bar);
            __builtin_amdgcn_fence(__ATOMIC_ACQUIRE, "agent");
            xb_add(&bar[XB_XGEN(b.x)], 1u);
            asm volatile("s_waitcnt vmcnt(0)" ::: "memory");
        } else {
            XB_SPIN(xb_ld(&bar[XB_XGEN(b.x)]) == gen, bar);
            __builtin_amdgcn_fence(__ATOMIC_ACQUIRE, "agent");
            asm volatile("s_waitcnt vmcnt(0)" ::: "memory");
        }
    }
    __syncthreads();
}

#define XB_LSUB(j)  (64 * (j))
#define XB_LGEN(j)  (1024 + 64 * (j))
#define XB_FLAG     2048
__device__ __forceinline__ void xcd_barrier_local(const XcdBarrier& b, unsigned* lw) {
    asm volatile("s_waitcnt vmcnt(0)" ::: "memory");
    __syncthreads();
    if (threadIdx.x == 0) {
        __builtin_amdgcn_s_waitcnt(0);
        const unsigned nloc = b.st[0];
        const unsigned old = xb_add(&lw[XB_LSUB(b.x)], 1u);
        const unsigned gen = old / nloc;
        if (old + 1u == (gen + 1u) * nloc) xb_add(&lw[XB_LGEN(b.x)], 1u);
        else XB_SPIN(xb_ld(&lw[XB_LGEN(b.x)]) == gen, b.bar);
    }
    __syncthreads();
}
__device__ unsigned g_bar_words[3 * XCD_BAR_WORDS];
template <bool MASK>
DI void sb_tile(f32x16& p0, f32x16& p1, float& cpos, int lim, int lo, int hi, bf16x8 (&pa)[4]) {
    float gs[4];
#pragma unroll
    for (int half = 0; half < 2; ++half) { f32x16& p = half ? p1 : p0;
#pragma unroll
        for (int g2 = 0; g2 < 2; ++g2) { float run = 0.f;
#pragma unroll
            for (int k = 7; k >= 0; --k) { const int r = 8 * g2 + k; const float z = p[r];
                float sp = fmaxf(z, 0.f) + lg2(1.f + ex2(-fabsf(z)));
                if (MASK) sp = (32 * half + 16 * g2 + k < lim && 32 * half + 16 * g2 + k >= lo) ? sp : 0.f;
                run += sp; p[r] = z - run; }
            gs[2 * half + g2] = run; } }
    float T[4];
    { float P[4], om[4];
#pragma unroll
      for (int i = 0; i < 4; ++i) { P[i] = xhalf_sum(gs[i]); om[i] = hi ? 0.f : (P[i] - gs[i]); }
      const float S2 = P[3], S1 = S2 + P[2], S0 = S1 + P[1];
      T[3] = cpos + om[3]; T[2] = cpos + S2 + om[2]; T[1] = cpos + S1 + om[1]; T[0] = cpos + S0 + om[0];
      cpos += S0 + P[0]; }
#pragma unroll
    for (int half = 0; half < 2; ++half) { f32x16& p = half ? p1 : p0;
#pragma unroll
        for (int g2 = 0; g2 < 2; ++g2) { float a[8];
#pragma unroll
            for (int k = 0; k < 8; ++k) { a[k] = ex2(p[8 * g2 + k] - T[2 * half + g2]); if (MASK) a[k] = (32 * half + 16 * g2 + k < lim && 32 * half + 16 * g2 + k >= lo) ? a[k] : 0.f; }
            v4u w; w.x = cvtpk(a[0], a[1]); w.y = cvtpk(a[2], a[3]); w.z = cvtpk(a[4], a[5]); w.w = cvtpk(a[6], a[7]);
            pa[2 * half + g2] = __builtin_bit_cast(bf16x8, w); } }
}
DI void dma16(const bf16* g, LAS unsigned char* l) { __builtin_amdgcn_global_load_lds((const unsigned*)g, (LAS unsigned*)l, 16, 0, 0); }
DI void gate_prefetch(const bf16* __restrict__ gate, LAS unsigned char* gl) {
#pragma unroll
    for (int f = 0; f < 4; ++f) dma16(gate + f * 512, gl + f * 1024);
}
DI void gated_store(const f32x16& o0, const f32x16& o1, float mul, const LAS unsigned char* gl, int lane, bf16* __restrict__ dst  ) {
    asm volatile("s_waitcnt vmcnt(0)" ::: "memory");
#pragma unroll
    for (int dh = 0; dh < 2; ++dh) { const f32x16& o = dh ? o1 : o0;
        const v4u g0 = *(const LAS v4u*)(gl + (2 * dh) * 1024 + lane * 16), g1 = *(const LAS v4u*)(gl + (2 * dh + 1) * 1024 + lane * 16);
        v4u w0, w1;
        w0.x = cvtpk(o[0] * mul * silu(bflo(g0.x)), o[1] * mul * silu(bfhi(g0.x))); w0.y = cvtpk(o[2] * mul * silu(bflo(g0.y)), o[3] * mul * silu(bfhi(g0.y)));
        w0.z = cvtpk(o[4] * mul * silu(bflo(g0.z)), o[5] * mul * silu(bfhi(g0.z))); w0.w = cvtpk(o[6] * mul * silu(bflo(g0.w)), o[7] * mul * silu(bfhi(g0.w)));
        w1.x = cvtpk(o[8] * mul * silu(bflo(g1.x)), o[9] * mul * silu(bfhi(g1.x))); w1.y = cvtpk(o[10] * mul * silu(bflo(g1.y)), o[11] * mul * silu(bfhi(g1.y)));
        w1.z = cvtpk(o[12] * mul * silu(bflo(g1.z)), o[13] * mul * silu(bfhi(g1.z))); w1.w = cvtpk(o[14] * mul * silu(bflo(g1.w)), o[15] * mul * silu(bfhi(g1.w)));
        *(v4u*)(dst + dh * 32) = w0; *(v4u*)(dst + dh * 32 + 8) = w1; }
    asm volatile("s_waitcnt lgkmcnt(0)" ::: "memory");
}
DI void sb_unit(const bf16* __restrict__ IMG, const bf16* __restrict__ VB, bf16* __restrict__ MIXED, int b, int h, int qt, int lane, LAS unsigned char* kl, LAS unsigned char* gl) {
    const int r32 = lane & 31, hi = lane >> 5;
    const size_t rowbase = (size_t)b * SEQ; const int tloc = qt * 32 + r32;
    const bf16* qp = IMG + (CG_Q + h) * IMG_CG + b * IMG_B + qt * IMG_TILE + lane * 8;
    const bf16* kbase = IMG + (CG_K + h) * IMG_CG + b * IMG_B + lane * 8;
    const bf16* vbase = VB + (size_t)(b * 8 + h) * (128 * 2 * 512) + lane * 8;
    int k0 = 32 * qt - 32;
#pragma unroll
    for (int half = 0; half < 2; ++half) { const int sbk = ((k0 >> 5) + half < 0) ? 0 : (k0 >> 5) + half;
#pragma unroll
        for (int d0 = 0; d0 < 4; ++d0) dma16(kbase + (sbk * 4 + d0) * 512, kl + (half * 4 + d0) * 1024); }
    gate_prefetch(IMG + (CG_SG + h) * IMG_CG + b * IMG_B + qt * IMG_TILE + lane * 8, gl);
    bf16x8 qr[4];
#pragma unroll
    for (int d0 = 0; d0 < 4; ++d0) qr[d0] = ld8(qp + d0 * 512);
    f32x16 o0 = {}, o1 = {};
    float cpos = 0.f;
    const LAS unsigned char* ks = kl + lane * 16;
    for (; k0 > -64; k0 -= 64) {
        asm volatile("s_waitcnt vmcnt(0)" ::: "memory");
        bf16x8 vf[4][2];
#pragma unroll
        for (int kb = 0; kb < 4; ++kb) { const int kbb = ((k0 >> 4) + kb < 0) ? 0 : (k0 >> 4) + kb;
#pragma unroll
            for (int dh = 0; dh < 2; ++dh) vf[kb][dh] = ld8(vbase + (kbb * 2 + dh) * 512); }
        f32x16 p0 = {}, p1 = {};
#pragma unroll
        for (int d0 = 0; d0 < 4; ++d0) { p0 = MFMA32(*(const LAS bf16x8*)(ks + d0 * 1024), qr[d0], p0); p1 = MFMA32(*(const LAS bf16x8*)(ks + (4 + d0) * 1024), qr[d0], p1); }
        asm volatile("s_waitcnt lgkmcnt(0)" ::: "memory");
        if (k0 - 64 > -64) { const int kn = k0 - 64;
#pragma unroll
            for (int half = 0; half < 2; ++half) { const int sbk = ((kn >> 5) + half < 0) ? 0 : (kn >> 5) + half;
#pragma unroll
                for (int d0 = 0; d0 < 4; ++d0) dma16(kbase + (sbk * 4 + d0) * 512, kl + (half * 4 + d0) * 1024); }
        }
        asm volatile("" ::: "memory");
        bf16x8 pa[4];
        if (k0 + 63 >= qt * 32 || k0 < 0) sb_tile<true>(p0, p1, cpos, tloc - k0 - 8 * hi, -k0 - 8 * hi, hi, pa);
        else sb_tile<false>(p0, p1, cpos, 64, 0, hi, pa);
#pragma unroll
        for (int kb = 0; kb < 4; ++kb) { o0 = MFMA32(vf[kb][0], pa[kb], o0); o1 = MFMA32(vf[kb][1], pa[kb], o1); }
#if SB_EARLY_EXIT
        if (__all(cpos > 160.f)) break;
#endif
    }
    asm volatile("s_waitcnt vmcnt(0)" ::: "memory");
    gated_store(o0, o1, 1.f, gl, lane, MIXED + (rowbase + tloc) * MIXP + MIX_SB + h * 64 + hi * 16);
}

DI void mem_unit(const bf16* __restrict__ IMG, const bf16* __restrict__ KM, const bf16* __restrict__ VMT, const float* __restrict__ qng, bf16* __restrict__ MIXED, int b, int hd, int qt, int lane, LAS unsigned char* gl, const LAS unsigned char* kst) {
    const int r32 = lane & 31, hi = lane >> 5;
    const size_t row = (size_t)b * SEQ + qt * 32 + r32;
    gate_prefetch(IMG + (CG_MG + hd) * IMG_CG + b * IMG_B + qt * IMG_TILE + lane * 8, gl);
    const bf16* qp = IMG + (CG_MQ + hd) * IMG_CG + b * IMG_B + qt * IMG_TILE + lane * 8;
    float qf[4][8]; float ss = 0.f;
#pragma unroll
    for (int d0 = 0; d0 < 4; ++d0) { const v4u w = *(const v4u*)(qp + d0 * 512);
        qf[d0][0] = bflo(w.x); qf[d0][1] = bfhi(w.x); qf[d0][2] = bflo(w.y); qf[d0][3] = bfhi(w.y); qf[d0][4] = bflo(w.z); qf[d0][5] = bfhi(w.z); qf[d0][6] = bflo(w.w); qf[d0][7] = bfhi(w.w);
#pragma unroll
        for (int j = 0; j < 8; ++j) ss += qf[d0][j] * qf[d0][j]; }
    ss = xhalf_sum(ss);
    const float rs = __builtin_amdgcn_rsqf(ss * (1.f / 64.f) + EPS);
    bf16x8 qr[4];
#pragma unroll
    for (int d0 = 0; d0 < 4; ++d0) { const float* gp = qng + d0 * 16 + hi * 8; float t[8];
#pragma unroll
        for (int j = 0; j < 8; ++j) t[j] = qf[d0][j] * rs * gp[j] * C2;
        v4u w; w.x = cvtpk(t[0], t[1]); w.y = cvtpk(t[2], t[3]); w.z = cvtpk(t[4], t[5]); w.w = cvtpk(t[6], t[7]); qr[d0] = __builtin_bit_cast(bf16x8, w); }
    const LAS unsigned char* kbase = kst + lane * 16;
    float mx = -3.0e38f;
#pragma unroll
    for (int kb = 0; kb < 8; ++kb) { f32x16 p = {};
#pragma unroll
        for (int d0 = 0; d0 < 4; ++d0) p = MFMA32(*(const LAS bf16x8*)(kbase + (kb * 4 + d0) * 1024), qr[d0], p);
#pragma unroll
        for (int r = 0; r < 16; ++r) mx = fmaxf(mx, p[r]); }
    mx = xhalf_max(mx);
    float l = 0.f;
    f32x16 o0 = {}, o1 = {};
    const bf16* vbase = VMT + (size_t)(b * 4 + hd) * (16 * 2 * 512) + lane * 8;
#pragma unroll
    for (int kb = 0; kb < 8; ++kb) { f32x16 p = {};
#pragma unroll
        for (int d0 = 0; d0 < 4; ++d0) p = MFMA32(*(const LAS bf16x8*)(kbase + (kb * 4 + d0) * 1024), qr[d0], p);
#pragma unroll
        for (int g2 = 0; g2 < 2; ++g2) { float a[8];
#pragma unroll
            for (int k = 0; k < 8; ++k) { a[k] = ex2(p[8 * g2 + k] - mx); l += a[k]; }
            v4u w; w.x = cvtpk(a[0], a[1]); w.y = cvtpk(a[2], a[3]); w.z = cvtpk(a[4], a[5]); w.w = cvtpk(a[6], a[7]);
            const bf16x8 pa = __builtin_bit_cast(bf16x8, w);
            o0 = MFMA32(ld8(vbase + ((2 * kb + g2) * 2) * 512), pa, o0);
            o1 = MFMA32(ld8(vbase + ((2 * kb + g2) * 2 + 1) * 512), pa, o1); } }
    l = xhalf_sum(l);
    gated_store(o0, o1, __builtin_amdgcn_rcpf(l), gl, lane, MIXED + row * MIXP + MIX_MEM + hd * 64 + hi * 16);
}

template <int G>
DI void pool_unit(const bf16* __restrict__ IMG, const bf16* __restrict__ PWT, const float* __restrict__ pscale, bf16* __restrict__ MIXED, int pt, int lane, LAS unsigned char* gl, LAS unsigned char* ml) {
    const int r32 = lane & 31, hi = lane >> 5;
    const int b = pt >> 6, tloc = (pt & 63) * 32 + r32;
    gate_prefetch(IMG + (CG_PG + G) * IMG_CG + b * IMG_B + (pt & 63) * IMG_TILE + lane * 8, gl);
    { const bf16* ug = IMG + (CG_PV + G) * IMG_CG + b * IMG_B + lane * 8; const int tl = pt & 63, tp = tl > 0 ? tl - 1 : 0;
#pragma unroll
      for (int cb = 0; cb < 4; ++cb) { dma16(ug + (tp * 4 + cb) * 512, ml + cb * 1024); dma16(ug + (tl * 4 + cb) * 512, ml + 4096 + cb * 1024); } }
    const size_t row = (size_t)b * SEQ + tloc;
    constexpr int W = 2 << G;
    const int cnt = (tloc + 1 < W) ? tloc + 1 : W;
    const float inv = 1.f / (float)cnt;
    asm volatile("s_waitcnt vmcnt(0)" ::: "memory");
    f32x16 o0 = {}, o1 = {};
    const bf16* wp = PWT + (size_t)(G * 64 + sigma_perm(r32)) * 64 + hi * 8;
#pragma unroll 1
    for (int cb = 0; cb < 4; ++cb) {
        constexpr int WB = W < 8 ? W : 8;
        float s[8], u0[8];
#pragma unroll
        for (int i0 = 0; i0 < W; i0 += WB) {
            v4u x[WB];
#pragma unroll
            for (int i = 0; i < WB; ++i) { const int rr = r32 - ((i0 + i < cnt) ? i0 + i : 0);
                x[i] = *(const LAS v4u*)(ml + (unsigned)((((rr >= 0) ? 4 : 0) + cb) * 1024 + hi * 512 + (rr & 31) * 16)); }
            if (i0 == 0) { u0[0] = bflo(x[0].x); u0[1] = bfhi(x[0].x); u0[2] = bflo(x[0].y); u0[3] = bfhi(x[0].y); u0[4] = bflo(x[0].z); u0[5] = bfhi(x[0].z); u0[6] = bflo(x[0].w); u0[7] = bfhi(x[0].w);
#pragma unroll
                for (int j = 0; j < 8; ++j) s[j] = u0[j]; }
#pragma unroll
            for (int i = (i0 == 0 ? 1 : 0); i < WB; ++i) { const float m = (i0 + i < cnt) ? 1.f : 0.f;
                s[0] += m * bflo(x[i].x); s[1] += m * bfhi(x[i].x); s[2] += m * bflo(x[i].y); s[3] += m * bfhi(x[i].y); s[4] += m * bflo(x[i].z); s[5] += m * bfhi(x[i].z); s[6] += m * bflo(x[i].w); s[7] += m * bfhi(x[i].w); }
        }
        float t[8];
#pragma unroll
        for (int j = 0; j < 8; ++j) t[j] = s[j] * inv - u0[j];
        v4u pw; pw.x = cvtpk(t[0], t[1]); pw.y = cvtpk(t[2], t[3]); pw.z = cvtpk(t[4], t[5]); pw.w = cvtpk(t[6], t[7]);
        const bf16x8 pb = __builtin_bit_cast(bf16x8, pw);
        o0 = MFMA32(ld8(wp + cb * 16), pb, o0);
        o1 = MFMA32(ld8(wp + (size_t)32 * 64 + cb * 16), pb, o1);
    }
    const float* sp = pscale + G * 64 + hi * 16;
#pragma unroll
    for (int r = 0; r < 16; ++r) { o0[r] *= sp[r]; o1[r] *= sp[32 + r]; }
    gated_store(o0, o1, 1.f, gl, lane, MIXED + row * MIXP + MIX_POOL + G * 64 + hi * 16);
}
struct Args { const float* x; const float* mem; const float* norm_g; const float* w_in; const float* pool_w; const float* pool_scale; const float* mem_norm_g;
              const float* w_mem_kv; const float* q_norm_g; const float* k_norm_g; const float* w_out; float* out; unsigned char* ws; };
__global__ void __launch_bounds__(512, 2) fwd_kernel(Args a) {
    extern __shared__ __attribute__((aligned(16))) unsigned char lds[];
    const int tid = threadIdx.x, lane = tid & 63, wave = __builtin_amdgcn_readfirstlane(tid >> 6);
    const int G = gridDim.x, bx = blockIdx.x;
    const int gw = bx * 8 + wave, gws = wave * G + bx, NGW = G * 8;
    unsigned char* ws = a.ws;
    bf16* XN = (bf16*)(ws + WS_XN); bf16* PROJ = (bf16*)(ws + WS_PROJ); bf16* VT = (bf16*)(ws + WS_VT); bf16* MIXED = (bf16*)(ws + WS_MIXED);
    bf16* WIN = (bf16*)(ws + WS_WIN); bf16* WV = (bf16*)(ws + WS_WV); bf16* WOUT = (bf16*)(ws + WS_WOUT); bf16* WKV = (bf16*)(ws + WS_WKV);
    bf16* MN = (bf16*)(ws + WS_MN); bf16* KM = (bf16*)(ws + WS_KM); bf16* VMT = (bf16*)(ws + WS_VMT); bf16* PWT = (bf16*)(ws + WS_PWT);
    PG8_LAS unsigned char* L = (PG8_LAS unsigned char*)lds;
    volatile LAS unsigned* MISC = (volatile LAS unsigned*)(L + 131072);
    if (tid < 64) MISC[tid] = 0u;
    __syncthreads();
    const XcdBarrier bar = xcd_barrier_post(g_bar_words, MISC);
    XcdBarrier barB = bar; barB.bar = g_bar_words + XCD_BAR_WORDS;
    unsigned* const lw = g_bar_words + 2 * XCD_BAR_WORDS;
    if (tid == 0 && (bar.x != (unsigned)(bx & 7) || G != 256)) __hip_atomic_fetch_or(&lw[XB_FLAG], 1u, __ATOMIC_RELAXED, __HIP_MEMORY_SCOPE_AGENT);

    {
        LAS float* scr = (LAS float*)(L + wave * 16384);
        constexpr int I_IN = (DM / 32) * (IN_WIDTH / 64), I_OUT = (DM / 32) * (DM / 64), I_KV = (DM / 32) * (512 / 64), I_PW = 4 * 2;
        constexpr int NITEMS = I_IN + I_OUT + I_KV + I_PW;
        for (int it = gws; it < NITEMS; it += NGW) {
            int r = it;
            if (r < I_IN) { const int n0 = 64 * (r % (IN_WIDTH / 64));
                if (n0 >= 1536 && n0 < 2048) p0_transpose_item(a.w_in, DM, IN_WIDTH, WV, -1536, scr, r, lane);
                else p0_transpose_item(a.w_in, DM, IN_WIDTH, WIN, n0 >= 2048 ? -512 : 0, scr, r, lane);
                continue; } r -= I_IN;
            if (r < I_OUT) { p0_transpose_item(a.w_out, DM, DM, WOUT, 0, scr, r, lane); continue; } r -= I_OUT;
            if (r < I_KV) { p0_transpose_item(a.w_mem_kv, DM, 512, WKV, 0, scr, r, lane, 1); continue; } r -= I_KV;
            { const int g = r >> 1; p0_transpose_item(a.pool_w + g * 4096, 64, 64, PWT + g * 4096, 0, scr, r & 1, lane); }
        }
        for (int m = gw; m < MROWS; m += NGW) rms_row_to_img(a.mem, a.mem_norm_g, MN, m, lane);
        for (int m = gw; m < MTOK; m += 4 * NGW) rms_rows_to_bf16<4>(a.x, a.norm_g, XN, m, NGW, MTOK, lane);
    }
    xcd_barrier(bar);
    const bool local_ok = __hip_atomic_load(&lw[XB_FLAG], __ATOMIC_RELAXED, __HIP_MEMORY_SCOPE_AGENT) == 0u;
    {
        pg8::Gemm g{XN, WIN, MTOK, PITCH, DM, DM, WV, XN}; pg8::DualOrder S; S.init(MTOK, PITCH, 512, MTOK, G, bx);
        pg8::EpiProjAll E{pg8::EpiImg{PROJ, C2}, pg8::EpiVblk{VT}};
        pg8::gemm_phase<pg8::EpiProjAll, pg8::DualOrder, true, true>(L, g, S, E);
    }
    for (int base = bx * 2; base < 512; base += G * 2) {
        int tile = base + (wave >> 2); const int kq = wave & 3;
        if (G == 256) { const int s = 2 * (bx >> 3) + (wave >> 2); tile = (s >> 5) * 256 + (8 * (bx & 7) + ((s >> 2) & 7)) * 4 + (s & 3); }
        f32x16 a0 = {}, a1 = {};
        memkv_partial(MN, WKV, tile, kq, lane, a0, a1);
        LAS float* red = (LAS float*)L + wave * 2048;
        if (kq != 0) {
#pragma unroll
            for (int r = 0; r < 16; ++r) { red[r * 64 + lane] = a0[r]; red[(16 + r) * 64 + lane] = a1[r]; } }
        __syncthreads();
        if (kq == 0) {
#pragma unroll
            for (int q = 1; q < 4; ++q)
#pragma unroll
                for (int r = 0; r < 16; ++r) { a0[r] += red[q * 2048 + r * 64 + lane]; a1[r] += red[q * 2048 + (16 + r) * 64 + lane]; }
            memkv_epilogue(a.k_norm_g, KM, VMT, tile, lane, a0, a1); }
        __syncthreads();
    }
    if (local_ok) xcd_barrier_local(bar, lw); else xcd_barrier(barB);
    LAS unsigned char* GL = L + 65536 + wave * 4096;
    const int gwv = (((G & 7) == 0) ? (bx & 7) * (G >> 3) + (bx >> 3) : bx) * 8 + wave;
#define P2_STAGE_K(u_) do { const bf16* kb_ = KM + (size_t)(((u_) >> 8) * 4 + (((u_) >> 6) & 3)) * (8 * 4 * 512) + lane * 8; \
        _Pragma("unroll") for (int f_ = 0; f_ < 4; ++f_) dma16(kb_ + (wave * 4 + f_) * 512, L + 98304 + (wave * 4 + f_) * 1024); } while (0)
    P2_STAGE_K(gwv);
    asm volatile("s_waitcnt vmcnt(0)" ::: "memory");
    __syncthreads();
    for (int u = gwv; u < BATCH * 8 * 32; u += NGW) { const int bh = u >> 5, i = u & 31;
#pragma unroll 1
        for (int rep = 0; rep < 2; ++rep) sb_unit(PROJ, VT, MIXED, bh >> 3, bh & 7, rep ? i : 63 - i, lane, L + wave * 8192, GL); }
    for (int u = gwv; u < BATCH * 4 * 64; u += NGW) {
        if (u != gwv) { __syncthreads(); P2_STAGE_K(u); asm volatile("s_waitcnt vmcnt(0)" ::: "memory"); __syncthreads(); }
        mem_unit(PROJ, KM, VMT, a.q_norm_g, MIXED, u >> 8, (u >> 6) & 3, u & 63, lane, GL, L + 98304); }
#undef P2_STAGE_K
    for (int u = gwv; u < (MTOK / 32) * 4; u += NGW) { const int pt = u >> 2, gs = u & 3, g = (pt & 1) ? 3 - gs : gs;
        if (g == 0) pool_unit<0>(PROJ, PWT, a.pool_scale, MIXED, pt, lane, GL, L + wave * 8192); else if (g == 1) pool_unit<1>(PROJ, PWT, a.pool_scale, MIXED, pt, lane, GL, L + wave * 8192);
        else if (g == 2) pool_unit<2>(PROJ, PWT, a.pool_scale, MIXED, pt, lane, GL, L + wave * 8192); else pool_unit<3>(PROJ, PWT, a.pool_scale, MIXED, pt, lane, GL, L + wave * 8192); }
    if (local_ok) xcd_barrier_local(bar, lw); else xcd_barrier(barB);
    {
        pg8::Gemm g{MIXED, WOUT, MTOK, DM, DM, MIXP, nullptr, nullptr}; pg8::StaticOrder S; S.init(MTOK, DM, G, bx);
        pg8::EpiResF32 E{a.x, a.out, DM, L + 131072 + 1024};
        pg8::gemm_phase<pg8::EpiResF32, pg8::StaticOrder, true, true>(L, g, S, E);
    }
}

extern "C" void kernel_launch(void* const* d_in, const int* in_sizes, int n_in, void* d_out, int out_size, void* d_ws, size_t ws_size, hipStream_t stream) {
    static int grid = 0;
    if (grid == 0) {
        if (n_in != 11 || out_size != MTOK * DM || ws_size < WS_END) { fprintf(stderr, "kernel_launch: unexpected shapes (n_in %d out %d ws %zu)\n", n_in, out_size, ws_size); grid = -1; return; }
        int dev = 0, cus = 0, per_cu = 0;
        hipGetDevice(&dev); hipDeviceGetAttribute(&cus, hipDeviceAttributeMultiprocessorCount, dev);
        hipFuncSetAttribute((const void*)fwd_kernel, hipFuncAttributeMaxDynamicSharedMemorySize, LDS_BYTES);
        hipOccupancyMaxActiveBlocksPerMultiprocessor(&per_cu, (const void*)fwd_kernel, 512, LDS_BYTES);
        if (per_cu < 1) { fprintf(stderr, "kernel_launch: occupancy query reports %d blocks per CU\n", per_cu); per_cu = 1; }
        grid = cus;
    }
    if (grid < 0) return;
    const size_t ws_off = (ws_size - WS_END) & ~(size_t)0xFFFFF;
    Args a{};
    a.x = (const float*)d_in[0]; a.mem = (const float*)d_in[1]; a.norm_g = (const float*)d_in[2]; a.w_in = (const float*)d_in[3]; a.pool_w = (const float*)d_in[4];
    a.pool_scale = (const float*)d_in[5]; a.mem_norm_g = (const float*)d_in[6]; a.w_mem_kv = (const float*)d_in[7]; a.q_norm_g = (const float*)d_in[8];
    a.k_norm_g = (const float*)d_in[9]; a.w_out = (const float*)d_in[10]; a.out = (float*)d_out; a.ws = (unsigned char*)d_ws + ws_off;
    void* args[] = {&a};
    hipError_t e = hipLaunchCooperativeKernel((const void*)fwd_kernel, dim3(grid), dim3(512), args, LDS_BYTES, stream);
    if (e != hipSuccess) fprintf(stderr, "cooperative launch failed: %s (grid %d)\n", hipGetErrorString(e), grid);
}
```

```cpp
#include <hip/hip_runtime.h>
#include <cstdio>
#include <cstdint>
namespace pg8 {
#define PG8_LAS __attribute__((address_space(3)))
typedef unsigned short bf16_t;
typedef short bf16x8 __attribute__((ext_vector_type(8)));
typedef float f32x4 __attribute__((ext_vector_type(4)));
typedef unsigned u32x4 __attribute__((ext_vector_type(4)));
constexpr int BM = 256, BK = 64, HALF = 128, HTB = HALF * BK * 2  , STAGE_BYTES = 8 * HTB, NXCD = 8, WGM = 8;

__host__ __device__ __forceinline__ int lds_byte(int r, int c) { const int st = (r >> 4) * 2 + (c >> 5), rr = r & 15, cc = c & 31, ob = rr * 64 + cc * 2; return st * 1024 + (ob ^ (((ob >> 9) & 1) << 5)); }
__host__ __device__ __forceinline__ void stage_rc(int b, int& R, int& C) { const int st = b / 1024, sb = b % 1024, swz = sb ^ (((sb >> 9) & 1) << 5); R = (st >> 1) * 16 + swz / 64; C = (st & 1) * 32 + (swz % 64) / 2; }
__host__ __device__ __forceinline__ int perm32(int rho) { const int n = rho >> 4, i = rho & 15; return 8 * (i >> 2) + 4 * n + (i & 3); }

struct Unit { int pm, pn, kind; };
struct Gemm { const bf16_t* A; const bf16_t* Bt; int M, N, K, lda; const bf16_t* A2; const bf16_t* Bt2; };

struct StaticOrder {
    int nM, nN, nwg, G, c;
    __host__ __device__ void init(int M, int N, int G_, int c_) { nM = M / BM; nN = N / BM; nwg = nM * nN; G = G_; c = c_; }
    __host__ __device__ bool next(int i, Unit& u) const {
        const long L = (long)i * G + c; if (L >= nwg) return false;
        int wgid = (int)L; { const int q = nwg / NXCD, r = nwg % NXCD, xcd = wgid % NXCD, off = wgid / NXCD; wgid = (xcd < r ? xcd * (q + 1) : r * (q + 1) + (xcd - r) * q) + off; }
        const int nig = WGM * nN, gid = wgid / nig, fm = gid * WGM, gsz = (nM - fm) < WGM ? (nM - fm) : WGM;
        u.pm = fm + ((wgid % nig) % gsz); u.pn = (wgid % nig) / gsz; u.kind = 0; return true;
    }
    __device__ __forceinline__ void a_ready(const Unit&) const {}
    __device__ __forceinline__ void done(const Unit&) const {}
};

struct DualOrder {
    StaticOrder S0, S1; int n0, n1, G, c;
    __host__ __device__ void init(int M0, int N0, int M1, int N1, int G_, int c_) { S0.init(M0, N0, 1, 0); S1.init(M1, N1, 1, 0); n0 = S0.nwg; n1 = S1.nwg; G = G_; c = c_; }
    __host__ __device__ bool next(int i, Unit& u) const {
        const long L = (long)i * G + c; if (L >= n0 + n1) return false;
        if (L < n0) { S0.next((int)L, u); u.kind = 0; } else { S1.next((int)(L - n0), u); u.kind = 1; }
        return true;
    }
    __device__ __forceinline__ void a_ready(const Unit&) const {}
    __device__ __forceinline__ void done(const Unit&) const {}
};

__device__ __forceinline__ unsigned cvt_pk_bf16(float lo, float hi) { unsigned r; asm volatile("v_cvt_pk_bf16_f32 %0, %1, %2" : "=v"(r) : "v"(lo), "v"(hi)); return r; }
typedef float f32x2 __attribute__((ext_vector_type(2)));
struct EpiBf16S {
    static constexpr bool PERM = true, AFTER_DRAIN = false, PREFETCH = false;
    bf16_t* O; int ldc; int q_lo, q_hi; float scale;
    __device__ __forceinline__ void operator()(const f32x4 (&acc)[2][2][4][2], const Unit& u, int wr, int wc, int fr, int fq) const {
        const int row0 = u.pm * BM + wr * 64 + fr; const int col0 = u.pn * BM + wc * 32 + 8 * fq;
        const float sc = (u.pn >= q_lo && u.pn < q_hi) ? scale : 1.f;
#pragma unroll
        for (int ai = 0; ai < 2; ++ai)
#pragma unroll
            for (int m = 0; m < 4; ++m) { bf16_t* rowp = O + (size_t)(row0 + ai * HALF + m * 16) * ldc + col0;
#pragma unroll
                for (int bj = 0; bj < 2; ++bj) { f32x4 v0 = acc[ai][bj][m][0] * sc, v1 = acc[ai][bj][m][1] * sc;
                    u32x4 w; w.x = cvt_pk_bf16(v0[0], v0[1]); w.y = cvt_pk_bf16(v0[2], v0[3]); w.z = cvt_pk_bf16(v1[0], v1[1]); w.w = cvt_pk_bf16(v1[2], v1[3]);
                    *(u32x4*)(rowp + bj * HALF) = w; } }
    }
};
struct EpiResF32 {
    static constexpr bool PERM = false, AFTER_DRAIN = false, PREFETCH = true;
    const float* base; float* out; int ldc; PG8_LAS unsigned char* pf;
    __device__ __forceinline__ void prefetch(const Unit& u, int wr, int wc, int fr, int fq, int wid, int slot) const {
        const int s = 31 - (slot & 31);
        const float* p = base + (size_t)(u.pm * BM + (s >> 4) * HALF + wr * 64 + ((s >> 2) & 3) * 16 + fr) * ldc + u.pn * BM + wc * 32 + 4 * fq + ((s >> 1) & 1) * HALF + (s & 1) * 16;
        __builtin_amdgcn_global_load_lds((const unsigned*)p, (PG8_LAS unsigned*)(pf + wid * 1024), 16, 0, 0);
    }
    __device__ __forceinline__ void operator()(const f32x4 (&acc)[2][2][4][2], const Unit& u, int wr, int wc, int fr, int fq) const {
        const float* __restrict__ bp = base; float* __restrict__ op = out;
        const int col0 = u.pn * BM + wc * 32 + 4 * fq;
#pragma unroll
        for (int ai = 0; ai < 2; ++ai) {
            f32x4 xv[4][2][2];
#pragma unroll
            for (int m = 0; m < 4; ++m) { const size_t off = (size_t)(u.pm * BM + ai * HALF + wr * 64 + m * 16 + fr) * ldc + col0;
#pragma unroll
                for (int bj = 0; bj < 2; ++bj)
#pragma unroll
                    for (int n = 0; n < 2; ++n) xv[m][bj][n] = *(const f32x4*)(bp + off + bj * HALF + n * 16); }
#pragma unroll
            for (int m = 0; m < 4; ++m) { const size_t off = (size_t)(u.pm * BM + ai * HALF + wr * 64 + m * 16 + fr) * ldc + col0;
#pragma unroll
                for (int bj = 0; bj < 2; ++bj)
#pragma unroll
                    for (int n = 0; n < 2; ++n) *(f32x4*)(op + off + bj * HALF + n * 16) = xv[m][bj][n] + acc[ai][bj][m][n]; }
        }
    }
};
struct EpiImg {
    static constexpr bool PERM = true, AFTER_DRAIN = false, PREFETCH = false;
    bf16_t* IMG; float scale;
    __device__ __forceinline__ void operator()(const f32x4 (&acc)[2][2][4][2], const Unit& u, int wr, int wc, int fr, int fq) const {
        const int row0 = u.pm * BM + wr * 64 + fr;
        const int pn = u.pn;
        const bool isO = (pn == 1 || pn == 6 || pn == 7 || pn == 9), isK = (pn == 4 || pn == 5);
        const float sc = (pn == 2 || pn == 3) ? scale : 1.f;
        const int c = (wc & 1) * 4 + fq;
        const int f = isO ? 2 * (c >> 2) + (c & 1) : (c >> 1), hs = isO ? (c >> 1) & 1 : (c & 1);
#pragma unroll
        for (int ai = 0; ai < 2; ++ai)
#pragma unroll
            for (int m = 0; m < 4; ++m) { const int row = row0 + ai * HALF + m * 16;
                const int b = row >> 11, t = row & 2047, tl = t & 31, rp = isK ? ((tl & 0x13) | ((tl & 4) << 1) | ((tl & 8) >> 1)) : tl;
#pragma unroll
                for (int bj = 0; bj < 2; ++bj) { f32x4 v0 = acc[ai][bj][m][0] * sc, v1 = acc[ai][bj][m][1] * sc;
                    u32x4 w; w.x = cvt_pk_bf16(v0[0], v0[1]); w.y = cvt_pk_bf16(v0[2], v0[3]); w.z = cvt_pk_bf16(v1[0], v1[1]); w.w = cvt_pk_bf16(v1[2], v1[3]);
                    const int cg = (pn * BM + bj * HALF + wc * 32) >> 6;
                    *(u32x4*)(IMG + ((((size_t)(cg * 8 + b) * 64 + (t >> 5)) * 4 + f) * 64 + hs * 32 + rp) * 8) = w; } }
    }
};
struct EpiVblk {
    static constexpr bool PERM = true, AFTER_DRAIN = false, PREFETCH = false;
    bf16_t* VB;
    __device__ __forceinline__ void operator()(const f32x4 (&acc)[2][2][4][2], const Unit& u, int wr, int wc, int fr, int fq) const {
        const int row0 = u.pm * BM + wr * 64 + fr; const int col0 = u.pn * BM + wc * 32 + 8 * fq;
#pragma unroll
        for (int ai = 0; ai < 2; ++ai)
#pragma unroll
            for (int m = 0; m < 4; ++m) { const int row = row0 + ai * HALF + m * 16; const int h = row >> 6, d = row & 63, dh = d >> 5, x = d & 31, si = (((x >> 2) & 3) << 3) | (((x >> 4) & 1) << 2) | (x & 3);
#pragma unroll
                for (int bj = 0; bj < 2; ++bj) { const f32x4 v0 = acc[ai][bj][m][0], v1 = acc[ai][bj][m][1];
                    u32x4 w; w.x = cvt_pk_bf16(v0[0], v0[1]); w.y = cvt_pk_bf16(v0[2], v0[3]); w.z = cvt_pk_bf16(v1[0], v1[1]); w.w = cvt_pk_bf16(v1[2], v1[3]);
                    const int n = col0 + bj * HALF, b = n >> 11, key = n & 2047;
                    *(u32x4*)(VB + ((((size_t)(b * 8 + h) * 128 + (key >> 4)) * 2 + dh) * 64 + ((key >> 3) & 1) * 32 + si) * 8) = w; } }
    }
};
struct EpiProjAll {
    static constexpr bool PERM = true, AFTER_DRAIN = false, PREFETCH = false;
    EpiImg img; EpiVblk vb;
    __device__ __forceinline__ void operator()(const f32x4 (&acc)[2][2][4][2], const Unit& u, int wr, int wc, int fr, int fq) const {
        if (u.kind) vb(acc, u, wr, wc, fr, fq); else img(acc, u, wr, wc, fr, fq);
    }
};
template <class Epi, class Sched, bool ALIGN_EPI = false, bool SP2 = false>
__device__ __forceinline__ void gemm_phase(PG8_LAS unsigned char* lds, const Gemm g, const Sched& S, const Epi& E) {
    int tid_ = threadIdx.x; asm volatile("" : "+v"(tid_));
    const int tid = tid_, wid = __builtin_amdgcn_readfirstlane(tid >> 6), lane = tid & 63, wr = wid >> 2, wc = wid & 3, fr = lane & 15, fq = lane >> 4;
    const int K = g.K, nt = K / BK;
    unsigned voffA[2], voffB[2];
#pragma unroll
    for (int i = 0; i < 2; ++i) { int R, C; stage_rc(tid * 16 + i * 8192, R, C); const int Rb = Epi::PERM ? ((R & ~31) + perm32(R & 31)) : R;
        voffA[i] = (unsigned)(R * g.lda + C) * 2u; voffB[i] = (unsigned)(Rb * K + C) * 2u; }
    const size_t kstep = (size_t)(BK * 2);
    const size_t hstep = (size_t)HALF * K * 2;
    const size_t tstep = 2 * hstep;
    const size_t hstepA = (size_t)HALF * g.lda * 2, tstepA = 2 * hstepA;
    const unsigned ldsw = (unsigned)wid * 1024u;
    const int aoff = lds_byte(wr * 64 + fr, fq * 8), boff = lds_byte(wc * 32 + fr, fq * 8);
#define PG8_SA(b, h) (((b) * 2 + (h)) * HTB)
#define PG8_SB(b, h) ((4 + (b) * 2 + (h)) * HTB)
#define PG8_STAGE(bufoff, gbase, voff) do { _Pragma("unroll") for (int _i = 0; _i < 2; ++_i) \
        __builtin_amdgcn_global_load_lds((const unsigned*)((const char*)(gbase) + (voff)[_i]), (PG8_LAS unsigned*)(lds + (bufoff) + ldsw + _i * 8192), 16, 0, 0); } while (0)
#define PG8_LDA(dst, b, h) do { _Pragma("unroll") for (int m = 0; m < 4; ++m) _Pragma("unroll") for (int k = 0; k < 2; ++k) dst[m][k] = *(const PG8_LAS bf16x8*)(lds + PG8_SA(b, h) + aoff + m * 2048 + k * 1024); } while (0)
#define PG8_LDB(dst, b, h) do { _Pragma("unroll") for (int n = 0; n < 2; ++n) _Pragma("unroll") for (int k = 0; k < 2; ++k) dst[n][k] = *(const PG8_LAS bf16x8*)(lds + PG8_SB(b, h) + boff + n * 2048 + k * 1024); } while (0)
#define PG8_MMA(ai, bj, At, Bt) do { __builtin_amdgcn_s_setprio(1); _Pragma("unroll") for (int m = 0; m < 4; ++m) _Pragma("unroll") for (int n = 0; n < 2; ++n) _Pragma("unroll") for (int k = 0; k < 2; ++k) \
        acc[ai][bj][m][n] = __builtin_amdgcn_mfma_f32_16x16x32_bf16(Bt[n][k], At[m][k], acc[ai][bj][m][n], 0, 0, 0); __builtin_amdgcn_s_setprio(0); } while (0)
#define PG8_WAIT_V(n) asm volatile("s_waitcnt vmcnt(" #n ")" ::: "memory")
#define PG8_WAIT_VP do { if constexpr (Epi::PREFETCH) asm volatile("s_waitcnt vmcnt(9)" ::: "memory"); else asm volatile("s_waitcnt vmcnt(8)" ::: "memory"); } while (0)
#define PG8_PF(j) do { if constexpr (Epi::PREFETCH) E.prefetch(cur, wr, wc, fr, fq, wid, (t >> 1) * 4 + (j)); } while (0)
#define PG8_WAIT_L(n) asm volatile("s_waitcnt lgkmcnt(" #n ")" ::: "memory")
#define PG8_BAR __builtin_amdgcn_s_barrier()
#define PG8_SCHED __builtin_amdgcn_sched_barrier(0)
    Unit cur, nxt; int ui = 0;
    if (!S.next(0, cur)) return;
    f32x4 acc[2][2][4][2];
#pragma unroll
    for (int a = 0; a < 2; ++a)
#pragma unroll
        for (int b = 0; b < 2; ++b)
#pragma unroll
            for (int m = 0; m < 4; ++m)
#pragma unroll
                for (int n = 0; n < 2; ++n) acc[a][b][m][n] = (f32x4){0.f, 0.f, 0.f, 0.f};
    bf16x8 At[4][2], B0[2][2], B1[2][2];
    const char* cA = (const char*)(cur.kind ? g.A2 : g.A) + (size_t)cur.pm * tstepA; const char* cB = (const char*)(cur.kind ? g.Bt2 : g.Bt) + (size_t)cur.pn * tstep;
    S.a_ready(cur);
    if constexpr (SP2) {
        PG8_STAGE(PG8_SB(0, 0), cB, voffB); PG8_STAGE(PG8_SB(0, 1), cB + hstep, voffB); PG8_STAGE(PG8_SA(0, 0), cA, voffA); PG8_STAGE(PG8_SA(0, 1), cA + hstepA, voffA);
        if (wr == 1) PG8_BAR;
        PG8_WAIT_V(2); PG8_BAR;
        PG8_STAGE(PG8_SB(1, 0), cB + kstep, voffB); PG8_STAGE(PG8_SA(1, 0), cA + kstep, voffA); PG8_STAGE(PG8_SB(1, 1), cB + hstep + kstep, voffB);
        PG8_WAIT_V(6); PG8_BAR;
    } else {
        PG8_STAGE(PG8_SB(0, 0), cB, voffB); PG8_STAGE(PG8_SA(0, 0), cA, voffA); PG8_STAGE(PG8_SB(0, 1), cB + hstep, voffB); PG8_STAGE(PG8_SA(0, 1), cA + hstepA, voffA);
        if (wr == 1) PG8_BAR;
        PG8_WAIT_V(4); PG8_BAR;
        PG8_STAGE(PG8_SB(1, 0), cB + kstep, voffB); PG8_STAGE(PG8_SA(1, 0), cA + kstep, voffA); PG8_STAGE(PG8_SB(1, 1), cB + hstep + kstep, voffB);
        PG8_WAIT_V(6); PG8_BAR;
    }
    for (;;) {
        const bool has_next = S.next(ui + 1, nxt);
        const char* nA = has_next ? (const char*)(nxt.kind ? g.A2 : g.A) + (size_t)nxt.pm * tstepA : cA; const char* nB = has_next ? (const char*)(nxt.kind ? g.Bt2 : g.Bt) + (size_t)nxt.pn * tstep : cB;
        for (int t = 0; t < nt; t += 2) {
            const bool last = (t == nt - 2);
            const char* a1 = cA + (size_t)(t + 1) * kstep;
            const char* a2 = last ? nA : cA + (size_t)(t + 2) * kstep; const char* b2 = last ? nB : cB + (size_t)(t + 2) * kstep;
            const char* a3 = a2 + kstep; const char* b3 = b2 + kstep;
            if (last && has_next) S.a_ready(nxt);
            if constexpr (SP2) {
            PG8_LDB(B0, 0, 0); PG8_LDB(B1, 0, 1); PG8_SCHED; PG8_LDA(At, 0, 0); PG8_PF(0); PG8_STAGE(PG8_SA(1, 1), a1 + hstepA, voffA);
            PG8_WAIT_VP; PG8_WAIT_L(0); PG8_BAR; PG8_MMA(0, 0, At, B0); PG8_MMA(0, 1, At, B1); PG8_BAR; PG8_SCHED;
            PG8_LDA(At, 0, 1); PG8_PF(1); PG8_STAGE(PG8_SB(0, 0), b2, voffB); PG8_STAGE(PG8_SB(0, 1), b2 + hstep, voffB); PG8_STAGE(PG8_SA(0, 0), a2, voffA);
            PG8_WAIT_VP; PG8_WAIT_L(0); PG8_BAR; PG8_MMA(1, 0, At, B0); PG8_MMA(1, 1, At, B1); PG8_BAR; PG8_SCHED;
            PG8_LDB(B0, 1, 0); PG8_LDB(B1, 1, 1); PG8_SCHED; PG8_LDA(At, 1, 0); PG8_PF(2); PG8_STAGE(PG8_SA(0, 1), a2 + hstepA, voffA);
            PG8_WAIT_VP; PG8_WAIT_L(0); PG8_BAR; PG8_MMA(0, 0, At, B0); PG8_MMA(0, 1, At, B1); PG8_BAR; PG8_SCHED;
            PG8_LDA(At, 1, 1); PG8_PF(3); PG8_STAGE(PG8_SB(1, 0), b3, voffB); PG8_STAGE(PG8_SB(1, 1), b3 + hstep, voffB); PG8_STAGE(PG8_SA(1, 0), a3, voffA);
            PG8_WAIT_VP; PG8_WAIT_L(0); PG8_BAR; PG8_MMA(1, 0, At, B0); PG8_MMA(1, 1, At, B1); PG8_BAR; PG8_SCHED;
            } else {
            PG8_LDB(B0, 0, 0); PG8_SCHED; PG8_LDA(At, 0, 0); PG8_STAGE(PG8_SA(1, 1), a1 + hstepA, voffA);
            PG8_WAIT_L(8); PG8_BAR; PG8_WAIT_L(0); PG8_MMA(0, 0, At, B0); PG8_BAR; PG8_SCHED;
            PG8_LDB(B1, 0, 1); PG8_STAGE(PG8_SB(0, 0), b2, voffB);
            PG8_BAR; PG8_WAIT_L(0); PG8_MMA(0, 1, At, B1); PG8_BAR;
            PG8_LDA(At, 0, 1); PG8_STAGE(PG8_SA(0, 0), a2, voffA);
            PG8_BAR; PG8_WAIT_L(0); PG8_MMA(1, 0, At, B0); PG8_BAR; PG8_SCHED;
            PG8_STAGE(PG8_SB(0, 1), b2 + hstep, voffB);
            PG8_WAIT_V(6); PG8_BAR; PG8_MMA(1, 1, At, B1); PG8_BAR;
            PG8_LDB(B0, 1, 0); PG8_SCHED; PG8_LDA(At, 1, 0); PG8_STAGE(PG8_SA(0, 1), a2 + hstepA, voffA);
            PG8_WAIT_L(8); PG8_BAR; PG8_WAIT_L(0); PG8_MMA(0, 0, At, B0); PG8_BAR; PG8_SCHED;
            PG8_LDB(B1, 1, 1); PG8_STAGE(PG8_SB(1, 0), b3, voffB);
            PG8_BAR; PG8_WAIT_L(0); PG8_MMA(0, 1, At, B1); PG8_BAR;
            PG8_LDA(At, 1, 1); PG8_STAGE(PG8_SA(1, 0), a3, voffA);
            PG8_BAR; PG8_WAIT_L(0); PG8_MMA(1, 0, At, B0); PG8_BAR; PG8_SCHED;
            PG8_STAGE(PG8_SB(1, 1), b3 + hstep, voffB);
            PG8_WAIT_V(6); PG8_BAR; PG8_MMA(1, 1, At, B1); PG8_BAR;
            }
        }
        if constexpr (ALIGN_EPI) { if (wr == 0) PG8_BAR; }
        if constexpr (!Epi::AFTER_DRAIN) { E(acc, cur, wr, wc, fr, fq); S.done(cur); }
        if (!has_next) break;
#pragma unroll
        for (int a = 0; a < 2; ++a)
#pragma unroll
            for (int b = 0; b < 2; ++b)
#pragma unroll
                for (int m = 0; m < 4; ++m)
#pragma unroll
                    for (int n = 0; n < 2; ++n) acc[a][b][m][n] = (f32x4){0.f, 0.f, 0.f, 0.f};
        cur = nxt; cA = nA; cB = nB; ++ui;
        if constexpr (ALIGN_EPI) { if (wr == 1) PG8_BAR; }
    }
    PG8_WAIT_V(0);
    if constexpr (!ALIGN_EPI) { if (wr == 0) PG8_BAR; }
    PG8_BAR;
    if constexpr (Epi::AFTER_DRAIN) { E.fused(acc, cur, wr, wc, fr, fq, lds, wid, lane); S.done(cur); }
#undef PG8_SA
#undef PG8_SB
#undef PG8_STAGE
#undef PG8_LDA
#undef PG8_LDB
#undef PG8_MMA
#undef PG8_WAIT_V
#undef PG8_WAIT_L
#undef PG8_WAIT_VP
#undef PG8_PF
#undef PG8_BAR
#undef PG8_SCHED
}
}
constexpr int BATCH = 8, SEQ = 2048, DM = 1024, MTOK = BATCH * SEQ;
constexpr int MEM_LEN = 256, MROWS = BATCH * MEM_LEN;
constexpr int IN_WIDTH = 3072;
constexpr int PITCH = 2560;
constexpr int COL_PV = 0, COL_PG = 256, COL_Q = 512, COL_K = 1024, COL_SG = 1536, COL_MQ = 2048, COL_MG = 2304;
constexpr int MIX_POOL = 0, MIX_SB = 256, MIX_MEM = 768;
constexpr int MIXP = 1088;
constexpr int CG_PV = 0, CG_PG = 4, CG_Q = 8, CG_K = 16, CG_SG = 24, CG_MQ = 32, CG_MG = 36;
constexpr size_t IMG_TILE = 4 * 512, IMG_B = 64 * IMG_TILE, IMG_CG = 8 * IMG_B;
constexpr float EPS = 1e-6f;
constexpr float LOG2E = 1.4426950408889634f;
constexpr float C2 = 0.125f * LOG2E;
#ifndef SB_EARLY_EXIT
#define SB_EARLY_EXIT 1
#endif
constexpr size_t MiB = 1u << 20;
constexpr size_t WS_WIN = 0, WS_WV = 5 * MiB, WS_WOUT = 6 * MiB, WS_WKV = 8 * MiB, WS_MN = 9 * MiB, WS_KM = 13 * MiB, WS_VMT = 14 * MiB, WS_PWT = 15 * MiB, WS_CTL = 15 * MiB + 512 * 1024,
                 WS_VT = 16 * MiB, WS_MIXED = 32 * MiB, WS_PROJ = 68 * MiB, WS_XN = 148 * MiB, WS_END = 180 * MiB;
constexpr size_t CTL_BYTES = 16384;
constexpr int LDS_BYTES = 131072 + 1024 + 8192;

#define LAS __attribute__((address_space(3)))
typedef unsigned short bf16;
typedef short bf16x8 __attribute__((ext_vector_type(8)));
typedef float f32x4 __attribute__((ext_vector_type(4)));
typedef float f32x16 __attribute__((ext_vector_type(16)));
typedef unsigned v4u __attribute__((ext_vector_type(4)));
typedef unsigned v2u __attribute__((ext_vector_type(2)));
typedef float f32x2_t __attribute__((ext_vector_type(2))); typedef __bf16 bf16x2_t __attribute__((ext_vector_type(2)));
#define DI __device__ __forceinline__
#define MFMA32(a, b, c) __builtin_amdgcn_mfma_f32_32x32x16_bf16((a), (b), (c), 0, 0, 0)
DI unsigned cvtpk(float lo, float hi) { f32x2_t v = {lo, hi}; bf16x2_t b = __builtin_convertvector(v, bf16x2_t); return __builtin_bit_cast(unsigned, b); }
DI float bflo(unsigned w) { return __uint_as_float(w << 16); }
DI float bfhi(unsigned w) { return __uint_as_float(w & 0xffff0000u); }
DI bf16x8 ld8(const bf16* p) { return *(const bf16x8*)p; }
DI float ex2(float x) { return __builtin_amdgcn_exp2f(x); }
DI float lg2(float x) { return __builtin_amdgcn_logf(x); }
DI float silu(float g) { return g * __builtin_amdgcn_rcpf(1.f + ex2(-g * LOG2E)); }
DI int pi_perm(int i) { return (i & 0x13) | ((i & 4) << 1) | ((i & 8) >> 1); }
DI int sigma_perm(int i) { return ((i >> 2) & 1) * 16 + (i >> 3) * 4 + (i & 3); }
DI float xhalf_sum(float v) { auto rr = __builtin_amdgcn_permlane32_swap(__float_as_uint(v), __float_as_uint(v), false, false); return __uint_as_float(rr[0]) + __uint_as_float(rr[1]); }
DI float xhalf_max(float v) { auto rr = __builtin_amdgcn_permlane32_swap(__float_as_uint(v), __float_as_uint(v), false, false); return fmaxf(__uint_as_float(rr[0]), __uint_as_float(rr[1])); }
DI float wave_sum(float v) {
#pragma unroll
    for (int o = 1; o < 64; o <<= 1) v += __shfl_xor(v, o);
    return v;
}
DI unsigned f2bf(float f) { unsigned u = __builtin_bit_cast(unsigned, f); return (u + 0x7fffu + ((u >> 16) & 1u)) >> 16; }
DI unsigned pk2(float lo, float hi) { return f2bf(lo) | (f2bf(hi) << 16); }

DI void p0_transpose_item(const float* W, int K, int N, bf16* WT, int row_off, LAS float* scr, int item, int lane, int img = 0) {
    const int nblk = N / 64, kb = item / nblk, nb = item % nblk, k0 = 32 * kb, n0 = 64 * nb;
    float t[32];
#pragma unroll
    for (int i = 0; i < 32; ++i) t[i] = W[(size_t)(k0 + i) * N + n0 + lane];
#pragma unroll
    for (int i = 0; i < 32; ++i) scr[i * 65 + lane] = t[i];
    asm volatile("s_waitcnt lgkmcnt(0)" ::: "memory");
    const int c = lane & 3;
#pragma unroll
    for (int j = 0; j < 4; ++j) { const int n = (lane >> 2) + 16 * j; const LAS float* s = scr + (8 * c) * 65 + n;
        v4u o; o.x = pk2(s[0 * 65], s[1 * 65]); o.y = pk2(s[2 * 65], s[3 * 65]); o.z = pk2(s[4 * 65], s[5 * 65]); o.w = pk2(s[6 * 65], s[7 * 65]);
        const int ng = row_off + n0 + n, kk = k0 + 8 * c;
        bf16* dst = img ? WT + ((size_t)(((ng >> 5) * (K >> 4) + (kk >> 4)) * 64 + ((kk >> 3) & 1) * 32 + (ng & 31))) * 8 : WT + (size_t)ng * K + kk;
        *(v4u*)dst = o; }
    asm volatile("s_waitcnt lgkmcnt(0)" ::: "memory");
}
template <int NR>
DI void rms_rows_to_bf16(const float* x, const float* g, bf16* out, int m0, int step, int mend, int lane) {
    f32x4 v[NR][4];
#pragma unroll
    for (int n = 0; n < NR; ++n) { const int m = (m0 + n * step < mend) ? m0 + n * step : m0; const f32x4* xr = (const f32x4*)(x + (size_t)m * DM) + lane;
#pragma unroll
        for (int j = 0; j < 4; ++j) v[n][j] = xr[64 * j]; }
    f32x4 gg[4];
#pragma unroll
    for (int j = 0; j < 4; ++j) gg[j] = ((const f32x4*)g + lane)[64 * j];
#pragma unroll
    for (int n = 0; n < NR; ++n) { float s = 0.f;
#pragma unroll
        for (int j = 0; j < 4; ++j) s += (v[n][j].x * v[n][j].x + v[n][j].y * v[n][j].y) + (v[n][j].z * v[n][j].z + v[n][j].w * v[n][j].w);
        const float r = __builtin_amdgcn_rsqf(wave_sum(s) * (1.f / DM) + EPS);
        const int m = m0 + n * step;
        if (m < mend) { unsigned long long* o8 = (unsigned long long*)(out + (size_t)m * DM) + lane;
#pragma unroll
            for (int j = 0; j < 4; ++j) o8[64 * j] = (unsigned long long)cvtpk(v[n][j].x * r * gg[j].x, v[n][j].y * r * gg[j].y) | ((unsigned long long)cvtpk(v[n][j].z * r * gg[j].z, v[n][j].w * r * gg[j].w) << 32); } }
}

DI void rms_row_to_img(const float* __restrict__ x, const float* __restrict__ g, bf16* __restrict__ MNI, int m, int lane) {
    const f32x4* xr = (const f32x4*)(x + (size_t)m * DM) + lane; const f32x4* gr = (const f32x4*)g + lane;
    f32x4 v[4]; float s = 0.f;
#pragma unroll
    for (int j = 0; j < 4; ++j) { v[j] = xr[64 * j]; s += (v[j].x * v[j].x + v[j].y * v[j].y) + (v[j].z * v[j].z + v[j].w * v[j].w); }
    const float r = __builtin_amdgcn_rsqf(wave_sum(s) * (1.f / DM) + EPS);
    const int rt = m >> 5, rl = m & 31;
#pragma unroll
    for (int j = 0; j < 4; ++j) { const f32x4 gg = gr[64 * j]; const int ks = (lane >> 2) + 16 * j;
        unsigned long long* o8 = (unsigned long long*)(MNI + ((size_t)((rt * 64 + ks) * 64 + ((lane >> 1) & 1) * 32 + rl)) * 8 + (lane & 1) * 4);
        *o8 = (unsigned long long)cvtpk(v[j].x * r * gg.x, v[j].y * r * gg.y) | ((unsigned long long)cvtpk(v[j].z * r * gg.z, v[j].w * r * gg.w) << 32); }
}

DI void memkv_partial(const bf16* __restrict__ MNI, const bf16* __restrict__ WKI, int tile, int kq, int lane, f32x16& a0, f32x16& a1) {
    const int r32 = lane & 31, hi = lane >> 5;
    const bool isV = tile >= 256; const int tt = tile & 255, rt = tt >> 2, hd = tt & 3;
    const int nt0 = ((isV ? 256 : 0) + hd * 64) >> 5;
    const int pslot = hi * 32 + sigma_perm(r32);
    if (!isV) {
        const bf16* wp0 = WKI + ((size_t)((nt0 * 64 + kq * 16) * 64 + pslot)) * 8; const bf16* wp1 = wp0 + (size_t)64 * 512;
        const bf16* mp = MNI + ((size_t)((rt * 64 + kq * 16) * 64 + lane)) * 8;
#pragma unroll
        for (int ks = 0; ks < 16; ++ks) { const bf16x8 bm = ld8(mp + ks * 512); a0 = MFMA32(ld8(wp0 + ks * 512), bm, a0); a1 = MFMA32(ld8(wp1 + ks * 512), bm, a1); }
    } else {
        const bf16* mp = MNI + ((size_t)((rt * 64 + kq * 16) * 64 + pslot)) * 8;
        const bf16* wp0 = WKI + ((size_t)((nt0 * 64 + kq * 16) * 64 + lane)) * 8; const bf16* wp1 = wp0 + (size_t)64 * 512;
#pragma unroll
        for (int ks = 0; ks < 16; ++ks) { const bf16x8 am = ld8(mp + ks * 512); a0 = MFMA32(am, ld8(wp0 + ks * 512), a0); a1 = MFMA32(am, ld8(wp1 + ks * 512), a1); }
    }
}
DI void memkv_epilogue(const float* __restrict__ kng, bf16* __restrict__ KM, bf16* __restrict__ VMT, int tile, int lane, const f32x16& a0, const f32x16& a1) {
    const int r32 = lane & 31, hi = lane >> 5;
    const bool isV = tile >= 256; const int tt = tile & 255, rt = tt >> 2, hd = tt & 3;
    if (!isV) {
        float ss = 0.f;
#pragma unroll
        for (int r = 0; r < 16; ++r) ss += a0[r] * a0[r] + a1[r] * a1[r];
        ss = xhalf_sum(ss);
        const float rs = __builtin_amdgcn_rsqf(ss * (1.f / 64.f) + EPS);
        bf16* op = KM + (((size_t)((rt >> 3) * 4 + hd) * 8 + (rt & 7)) * 4 + hi) * 512 + pi_perm(r32) * 8;
#pragma unroll
        for (int cb = 0; cb < 2; ++cb) { const f32x16& a = cb ? a1 : a0; const float* gp = kng + cb * 32 + hi * 16;
            v4u w0, w1;
            w0.x = cvtpk(a[0] * rs * gp[0], a[1] * rs * gp[1]); w0.y = cvtpk(a[2] * rs * gp[2], a[3] * rs * gp[3]); w0.z = cvtpk(a[4] * rs * gp[4], a[5] * rs * gp[5]); w0.w = cvtpk(a[6] * rs * gp[6], a[7] * rs * gp[7]);
            w1.x = cvtpk(a[8] * rs * gp[8], a[9] * rs * gp[9]); w1.y = cvtpk(a[10] * rs * gp[10], a[11] * rs * gp[11]); w1.z = cvtpk(a[12] * rs * gp[12], a[13] * rs * gp[13]); w1.w = cvtpk(a[14] * rs * gp[14], a[15] * rs * gp[15]);
            *(v4u*)(op + cb * 2 * 512) = w0; *(v4u*)(op + cb * 2 * 512 + 256) = w1; }
    } else {
        const int b = rt >> 3, m0 = (rt & 7) * 32 + hi * 16;
#pragma unroll
        for (int cb = 0; cb < 2; ++cb) { const f32x16& a = cb ? a1 : a0;
            const int si = (((r32 >> 2) & 3) << 3) | (((r32 >> 4) & 1) << 2) | (r32 & 3);
            bf16* op = VMT + ((((size_t)(b * 4 + hd) * 16 + (m0 >> 4)) * 2 + cb) * 64 + si) * 8;
            v4u w0, w1;
            w0.x = cvtpk(a[0], a[1]); w0.y = cvtpk(a[2], a[3]); w0.z = cvtpk(a[4], a[5]); w0.w = cvtpk(a[6], a[7]);
            w1.x = cvtpk(a[8], a[9]); w1.y = cvtpk(a[10], a[11]); w1.z = cvtpk(a[12], a[13]); w1.w = cvtpk(a[14], a[15]);
            *(v4u*)(op) = w0; *(v4u*)(op + 256) = w1; }
    }
}
#define XB_TMO      128
#define XB_XCNT(j)  (256  + 64 * (j))
#define XB_XSUB(j)  (1280 + 64 * (j))
#define XB_XGEN(j)  (2304 + 64 * (j))
#define XB_TOP      3328
#define XB_TOPGEN   3392
#define XCD_BAR_WORDS 3456
#define XB_BARRIERS_PER_LAUNCH 1u
#define XB_SPIN_CAP (1u << 18)

__device__ __forceinline__ unsigned xb_ld(unsigned* p)              { return __hip_atomic_load(p, __ATOMIC_RELAXED, __HIP_MEMORY_SCOPE_AGENT); }
__device__ __forceinline__ unsigned xb_add(unsigned* p, unsigned v) { return __hip_atomic_fetch_add(p, v, __ATOMIC_RELAXED, __HIP_MEMORY_SCOPE_AGENT); }
__device__ __forceinline__ unsigned xb_xcc_id() { return (unsigned)__builtin_amdgcn_s_getreg((3 << 11) | 20) & 0xFu; }
#define XB_SPIN(cond, bar) do { unsigned _sp = 0; while (cond) { __builtin_amdgcn_s_sleep(1); \
    if ((++_sp & 255u) == 0u) { if (xb_ld(&(bar)[XB_TMO])) break; if (_sp > XB_SPIN_CAP) { atomicAdd(&(bar)[XB_TMO], 1u); break; } } } } while (0)

struct XcdBarrier {
    unsigned* bar; unsigned x; unsigned calls;
    volatile LAS unsigned* st;
};

__device__ __forceinline__ XcdBarrier xcd_barrier_post(unsigned* bar, volatile LAS unsigned* st) {
    XcdBarrier b; b.bar = bar; b.x = xb_xcc_id(); b.st = st;
    b.calls = xb_ld(&bar[XB_TOPGEN]) / XB_BARRIERS_PER_LAUNCH;
    if (threadIdx.x == 0) (void)xb_add(&bar[XB_XCNT(b.x)], 1u);
    return b;
}
__device__ __forceinline__ void xcd_barrier_complete(unsigned* bar, unsigned x, unsigned calls, unsigned& nloc, unsigned& nx) {
    const unsigned G = gridDim.x * gridDim.y * gridDim.z * (calls + 1u);
    unsigned sum, cnt, mine, sp = 0u;
    for (;;) {
        sum = 0u; cnt = 0u; mine = 0u;
#pragma unroll
        for (unsigned j = 0; j < 16; ++j) { const unsigned c = xb_ld(&bar[XB_XCNT(j)]); sum += c; cnt += (c > 0u) ? 1u : 0u; mine = (j == x) ? c : mine; }
        if (sum == G) break;
        __builtin_amdgcn_s_sleep(1);
        if ((++sp & 255u) == 0u) { if (xb_ld(&bar[XB_TMO])) break; if (sp > XB_SPIN_CAP) { atomicAdd(&bar[XB_TMO], 1u); break; } }
    }
    mine /= (calls + 1u); nloc = mine > 0u ? mine : 1u; nx = cnt > 0u ? cnt : 1u;
}

__device__ __forceinline__ void xcd_barrier(const XcdBarrier& b) {
    asm volatile("s_waitcnt vmcnt(0)" ::: "memory");
    __syncthreads();
    if (threadIdx.x == 0) {
        unsigned* bar = b.bar;
        __builtin_amdgcn_s_waitcnt(0);
        unsigned nloc = b.st[0], nx = b.st[1];
        if (nloc == 0u) { xcd_barrier_complete(bar, b.x, b.calls, nloc, nx); b.st[0] = nloc; b.st[1] = nx; }
        const unsigned old = xb_add(&bar[XB_XSUB(b.x)], 1u);
        const unsigned gen = old / nloc;
        if (old + 1u == (gen + 1u) * nloc) {
            __builtin_amdgcn_fence(__ATOMIC_RELEASE, "agent");
            asm volatile("s_waitcnt vmcnt(0)" ::: "memory");
            const unsigned og = xb_add(&bar[XB_TOP], 1u);
            const unsigned tg = og / nx;
            if (og + 1u == (tg + 1u) * nx) xb_add(&bar[XB_TOPGEN], 1u);
            else XB_SPIN(xb_ld(&bar[XB_TOPGEN]) == tg, bar);
            __builtin_amdgcn_fence(__ATOMIC_ACQUIRE, "agent");
            xb_add(&bar[XB_XGEN(b.x)], 1u);
            asm volatile("s_waitcnt vmcnt(0)" ::: "memory");
        } else {
            XB_SPIN(xb_ld(&bar[XB_XGEN(b.x)]) == gen, bar);
            __builtin_amdgcn_fence(__ATOMIC_ACQUIRE, "agent");
            asm volatile("s_waitcnt vmcnt(0)" ::: "memory");
        }
    }
    __syncthreads();
}

#define XB_LSUB(j)  (64 * (j))
#define XB_LGEN(j)  (1024 + 64 * (j))
#define XB_FLAG     2048
__device__ __forceinline__ void xcd_barrier_local(const XcdBarrier& b, unsigned* lw) {
    asm volatile("s_waitcnt vmcnt(0)" ::: "memory");
    __syncthreads();
    if (threadIdx.x == 0) {
        __builtin_amdgcn_s_waitcnt(0);
        const unsigned nloc = b.st[0];
        const unsigned old = xb_add(&lw[XB_LSUB(b.x)], 1u);
        const unsigned gen = old / nloc;
        if (old + 1u == (gen + 1u) * nloc) xb_add(&lw[XB_LGEN(b.x)], 1u);
        else XB_SPIN(xb_ld(&lw[XB_LGEN(b.x)]) == gen, b.bar);
    }
    __syncthreads();
}
__device__ unsigned g_bar_words[3 * XCD_BAR_WORDS];
template <bool MASK>
DI void sb_tile(f32x16& p0, f32x16& p1, float& cpos, int lim, int lo, int hi, bf16x8 (&pa)[4]) {
    float gs[4];
#pragma unroll
    for (int half = 0; half < 2; ++half) { f32x16& p = half ? p1 : p0;
#pragma unroll
        for (int g2 = 0; g2 < 2; ++g2) { float run = 0.f;
#pragma unroll
            for (int k = 7; k >= 0; --k) { const int r = 8 * g2 + k; const float z = p[r];
                float sp = fmaxf(z, 0.f) + lg2(1.f + ex2(-fabsf(z)));
                if (MASK) sp = (32 * half + 16 * g2 + k < lim && 32 * half + 16 * g2 + k >= lo) ? sp : 0.f;
                run += sp; p[r] = z - run; }
            gs[2 * half + g2] = run; } }
    float T[4];
    { float P[4], om[4];
#pragma unroll
      for (int i = 0; i < 4; ++i) { P[i] = xhalf_sum(gs[i]); om[i] = hi ? 0.f : (P[i] - gs[i]); }
      const float S2 = P[3], S1 = S2 + P[2], S0 = S1 + P[1];
      T[3] = cpos + om[3]; T[2] = cpos + S2 + om[2]; T[1] = cpos + S1 + om[1]; T[0] = cpos + S0 + om[0];
      cpos += S0 + P[0]; }
#pragma unroll
    for (int half = 0; half < 2; ++half) { f32x16& p = half ? p1 : p0;
#pragma unroll
        for (int g2 = 0; g2 < 2; ++g2) { float a[8];
#pragma unroll
            for (int k = 0; k < 8; ++k) { a[k] = ex2(p[8 * g2 + k] - T[2 * half + g2]); if (MASK) a[k] = (32 * half + 16 * g2 + k < lim && 32 * half + 16 * g2 + k >= lo) ? a[k] : 0.f; }
            v4u w; w.x = cvtpk(a[0], a[1]); w.y = cvtpk(a[2], a[3]); w.z = cvtpk(a[4], a[5]); w.w = cvtpk(a[6], a[7]);
            pa[2 * half + g2] = __builtin_bit_cast(bf16x8, w); } }
}
DI void dma16(const bf16* g, LAS unsigned char* l) { __builtin_amdgcn_global_load_lds((const unsigned*)g, (LAS unsigned*)l, 16, 0, 0); }
DI void gate_prefetch(const bf16* __restrict__ gate, LAS unsigned char* gl) {
#pragma unroll
    for (int f = 0; f < 4; ++f) dma16(gate + f * 512, gl + f * 1024);
}
DI void gated_store(const f32x16& o0, const f32x16& o1, float mul, const LAS unsigned char* gl, int lane, bf16* __restrict__ dst  ) {
    asm volatile("s_waitcnt vmcnt(0)" ::: "memory");
#pragma unroll
    for (int dh = 0; dh < 2; ++dh) { const f32x16& o = dh ? o1 : o0;
        const v4u g0 = *(const LAS v4u*)(gl + (2 * dh) * 1024 + lane * 16), g1 = *(const LAS v4u*)(gl + (2 * dh + 1) * 1024 + lane * 16);
        v4u w0, w1;
        w0.x = cvtpk(o[0] * mul * silu(bflo(g0.x)), o[1] * mul * silu(bfhi(g0.x))); w0.y = cvtpk(o[2] * mul * silu(bflo(g0.y)), o[3] * mul * silu(bfhi(g0.y)));
        w0.z = cvtpk(o[4] * mul * silu(bflo(g0.z)), o[5] * mul * silu(bfhi(g0.z))); w0.w = cvtpk(o[6] * mul * silu(bflo(g0.w)), o[7] * mul * silu(bfhi(g0.w)));
        w1.x = cvtpk(o[8] * mul * silu(bflo(g1.x)), o[9] * mul * silu(bfhi(g1.x))); w1.y = cvtpk(o[10] * mul * silu(bflo(g1.y)), o[11] * mul * silu(bfhi(g1.y)));
        w1.z = cvtpk(o[12] * mul * silu(bflo(g1.z)), o[13] * mul * silu(bfhi(g1.z))); w1.w = cvtpk(o[14] * mul * silu(bflo(g1.w)), o[15] * mul * silu(bfhi(g1.w)));
        *(v4u*)(dst + dh * 32) = w0; *(v4u*)(dst + dh * 32 + 8) = w1; }
    asm volatile("s_waitcnt lgkmcnt(0)" ::: "memory");
}
DI void sb_unit(const bf16* __restrict__ IMG, const bf16* __restrict__ VB, bf16* __restrict__ MIXED, int b, int h, int qt, int lane, LAS unsigned char* kl, LAS unsigned char* gl) {
    const int r32 = lane & 31, hi = lane >> 5;
    const size_t rowbase = (size_t)b * SEQ; const int tloc = qt * 32 + r32;
    const bf16* qp = IMG + (CG_Q + h) * IMG_CG + b * IMG_B + qt * IMG_TILE + lane * 8;
    const bf16* kbase = IMG + (CG_K + h) * IMG_CG + b * IMG_B + lane * 8;
    const bf16* vbase = VB + (size_t)(b * 8 + h) * (128 * 2 * 512) + lane * 8;
    int k0 = 32 * qt - 32;
#pragma unroll
    for (int half = 0; half < 2; ++half) { const int sbk = ((k0 >> 5) + half < 0) ? 0 : (k0 >> 5) + half;
#pragma unroll
        for (int d0 = 0; d0 < 4; ++d0) dma16(kbase + (sbk * 4 + d0) * 512, kl + (half * 4 + d0) * 1024); }
    gate_prefetch(IMG + (CG_SG + h) * IMG_CG + b * IMG_B + qt * IMG_TILE + lane * 8, gl);
    bf16x8 qr[4];
#pragma unroll
    for (int d0 = 0; d0 < 4; ++d0) qr[d0] = ld8(qp + d0 * 512);
    f32x16 o0 = {}, o1 = {};
    float cpos = 0.f;
    const LAS unsigned char* ks = kl + lane * 16;
    for (; k0 > -64; k0 -= 64) {
        asm volatile("s_waitcnt vmcnt(0)" ::: "memory");
        f32x16 p0 = {}, p1 = {};
        __builtin_amdgcn_s_setprio(1);
#pragma unroll
        for (int d0 = 0; d0 < 4; ++d0) { p0 = MFMA32(*(const LAS bf16x8*)(ks + d0 * 1024), qr[d0], p0); p1 = MFMA32(*(const LAS bf16x8*)(ks + (4 + d0) * 1024), qr[d0], p1); }
        __builtin_amdgcn_s_setprio(0);
        asm volatile("s_waitcnt lgkmcnt(0)" ::: "memory");
        if (k0 - 64 > -64) { const int kn = k0 - 64;
#pragma unroll
            for (int half = 0; half < 2; ++half) { const int sbk = ((kn >> 5) + half < 0) ? 0 : (kn >> 5) + half;
#pragma unroll
                for (int d0 = 0; d0 < 4; ++d0) dma16(kbase + (sbk * 4 + d0) * 512, kl + (half * 4 + d0) * 1024); }
        }
        bf16x8 vf[4][2];
#pragma unroll
        for (int kb = 0; kb < 4; ++kb) { const int kbb = ((k0 >> 4) + kb < 0) ? 0 : (k0 >> 4) + kb;
#pragma unroll
            for (int dh = 0; dh < 2; ++dh) vf[kb][dh] = ld8(vbase + (kbb * 2 + dh) * 512); }
        asm volatile("" ::: "memory");
        bf16x8 pa[4];
        if (k0 + 63 >= qt * 32 || k0 < 0) sb_tile<true>(p0, p1, cpos, tloc - k0 - 8 * hi, -k0 - 8 * hi, hi, pa);
        else sb_tile<false>(p0, p1, cpos, 64, 0, hi, pa);
        __builtin_amdgcn_s_setprio(1);
#pragma unroll
        for (int kb = 0; kb < 4; ++kb) { o0 = MFMA32(vf[kb][0], pa[kb], o0); o1 = MFMA32(vf[kb][1], pa[kb], o1); }
        __builtin_amdgcn_s_setprio(0);
#if SB_EARLY_EXIT
        if (__all(cpos > 160.f)) break;
#endif
    }
    asm volatile("s_waitcnt vmcnt(0)" ::: "memory");
    gated_store(o0, o1, 1.f, gl, lane, MIXED + (rowbase + tloc) * MIXP + MIX_SB + h * 64 + hi * 16);
}

DI void mem_unit(const bf16* __restrict__ IMG, const bf16* __restrict__ KM, const bf16* __restrict__ VMT, const float* __restrict__ qng, bf16* __restrict__ MIXED, int b, int hd, int qt, int lane, LAS unsigned char* gl, const LAS unsigned char* kst) {
    const int r32 = lane & 31, hi = lane >> 5;
    const size_t row = (size_t)b * SEQ + qt * 32 + r32;
    gate_prefetch(IMG + (CG_MG + hd) * IMG_CG + b * IMG_B + qt * IMG_TILE + lane * 8, gl);
    const bf16* qp = IMG + (CG_MQ + hd) * IMG_CG + b * IMG_B + qt * IMG_TILE + lane * 8;
    float qf[4][8]; float ss = 0.f;
#pragma unroll
    for (int d0 = 0; d0 < 4; ++d0) { const v4u w = *(const v4u*)(qp + d0 * 512);
        qf[d0][0] = bflo(w.x); qf[d0][1] = bfhi(w.x); qf[d0][2] = bflo(w.y); qf[d0][3] = bfhi(w.y); qf[d0][4] = bflo(w.z); qf[d0][5] = bfhi(w.z); qf[d0][6] = bflo(w.w); qf[d0][7] = bfhi(w.w);
#pragma unroll
        for (int j = 0; j < 8; ++j) ss += qf[d0][j] * qf[d0][j]; }
    ss = xhalf_sum(ss);
    const float rs = __builtin_amdgcn_rsqf(ss * (1.f / 64.f) + EPS);
    bf16x8 qr[4];
#pragma unroll
    for (int d0 = 0; d0 < 4; ++d0) { const float* gp = qng + d0 * 16 + hi * 8; float t[8];
#pragma unroll
        for (int j = 0; j < 8; ++j) t[j] = qf[d0][j] * rs * gp[j] * C2;
        v4u w; w.x = cvtpk(t[0], t[1]); w.y = cvtpk(t[2], t[3]); w.z = cvtpk(t[4], t[5]); w.w = cvtpk(t[6], t[7]); qr[d0] = __builtin_bit_cast(bf16x8, w); }
    const LAS unsigned char* kbase = kst + lane * 16;
    float mx = -3.0e38f;
#pragma unroll
    for (int kb = 0; kb < 8; ++kb) { f32x16 p = {};
#pragma unroll
        for (int d0 = 0; d0 < 4; ++d0) p = MFMA32(*(const LAS bf16x8*)(kbase + (kb * 4 + d0) * 1024), qr[d0], p);
#pragma unroll
        for (int r = 0; r < 16; ++r) mx = fmaxf(mx, p[r]); }
    mx = xhalf_max(mx);
    float l = 0.f;
    f32x16 o0 = {}, o1 = {};
    const bf16* vbase = VMT + (size_t)(b * 4 + hd) * (16 * 2 * 512) + lane * 8;
#pragma unroll
    for (int kb = 0; kb < 8; ++kb) { f32x16 p = {};
#pragma unroll
        for (int d0 = 0; d0 < 4; ++d0) p = MFMA32(*(const LAS bf16x8*)(kbase + (kb * 4 + d0) * 1024), qr[d0], p);
#pragma unroll
        for (int g2 = 0; g2 < 2; ++g2) { float a[8];
#pragma unroll
            for (int k = 0; k < 8; ++k) { a[k] = ex2(p[8 * g2 + k] - mx); l += a[k]; }
            v4u w; w.x = cvtpk(a[0], a[1]); w.y = cvtpk(a[2], a[3]); w.z = cvtpk(a[4], a[5]); w.w = cvtpk(a[6], a[7]);
            const bf16x8 pa = __builtin_bit_cast(bf16x8, w);
            o0 = MFMA32(ld8(vbase + ((2 * kb + g2) * 2) * 512), pa, o0);
            o1 = MFMA32(ld8(vbase + ((2 * kb + g2) * 2 + 1) * 512), pa, o1); } }
    l = xhalf_sum(l);
    gated_store(o0, o1, __builtin_amdgcn_rcpf(l), gl, lane, MIXED + row * MIXP + MIX_MEM + hd * 64 + hi * 16);
}

template <int G>
DI void pool_unit(const bf16* __restrict__ IMG, const bf16* __restrict__ PWT, const float* __restrict__ pscale, bf16* __restrict__ MIXED, int pt, int lane, LAS unsigned char* gl, LAS unsigned char* ml) {
    const int r32 = lane & 31, hi = lane >> 5;
    const int b = pt >> 6, tloc = (pt & 63) * 32 + r32;
    gate_prefetch(IMG + (CG_PG + G) * IMG_CG + b * IMG_B + (pt & 63) * IMG_TILE + lane * 8, gl);
    { const bf16* ug = IMG + (CG_PV + G) * IMG_CG + b * IMG_B + lane * 8; const int tl = pt & 63, tp = tl > 0 ? tl - 1 : 0;
#pragma unroll
      for (int cb = 0; cb < 4; ++cb) { dma16(ug + (tp * 4 + cb) * 512, ml + cb * 1024); dma16(ug + (tl * 4 + cb) * 512, ml + 4096 + cb * 1024); } }
    const size_t row = (size_t)b * SEQ + tloc;
    constexpr int W = 2 << G;
    const int cnt = (tloc + 1 < W) ? tloc + 1 : W;
    const float inv = 1.f / (float)cnt;
    asm volatile("s_waitcnt vmcnt(0)" ::: "memory");
    f32x16 o0 = {}, o1 = {};
    const bf16* wp = PWT + (size_t)(G * 64 + sigma_perm(r32)) * 64 + hi * 8;
#pragma unroll 1
    for (int cb = 0; cb < 4; ++cb) {
        constexpr int WB = W < 8 ? W : 8;
        float s[8], u0[8];
#pragma unroll
        for (int i0 = 0; i0 < W; i0 += WB) {
            v4u x[WB];
#pragma unroll
            for (int i = 0; i < WB; ++i) { const int rr = r32 - ((i0 + i < cnt) ? i0 + i : 0);
                x[i] = *(const LAS v4u*)(ml + (unsigned)((((rr >= 0) ? 4 : 0) + cb) * 1024 + hi * 512 + (rr & 31) * 16)); }
            if (i0 == 0) { u0[0] = bflo(x[0].x); u0[1] = bfhi(x[0].x); u0[2] = bflo(x[0].y); u0[3] = bfhi(x[0].y); u0[4] = bflo(x[0].z); u0[5] = bfhi(x[0].z); u0[6] = bflo(x[0].w); u0[7] = bfhi(x[0].w);
#pragma unroll
                for (int j = 0; j < 8; ++j) s[j] = u0[j]; }
#pragma unroll
            for (int i = (i0 == 0 ? 1 : 0); i < WB; ++i) { const float m = (i0 + i < cnt) ? 1.f : 0.f;
                s[0] += m * bflo(x[i].x); s[1] += m * bfhi(x[i].x); s[2] += m * bflo(x[i].y); s[3] += m * bfhi(x[i].y); s[4] += m * bflo(x[i].z); s[5] += m * bfhi(x[i].z); s[6] += m * bflo(x[i].w); s[7] += m * bfhi(x[i].w); }
        }
        float t[8];
#pragma unroll
        for (int j = 0; j < 8; ++j) t[j] = s[j] * inv - u0[j];
        v4u pw; pw.x = cvtpk(t[0], t[1]); pw.y = cvtpk(t[2], t[3]); pw.z = cvtpk(t[4], t[5]); pw.w = cvtpk(t[6], t[7]);
        const bf16x8 pb = __builtin_bit_cast(bf16x8, pw);
        o0 = MFMA32(ld8(wp + cb * 16), pb, o0);
        o1 = MFMA32(ld8(wp + (size_t)32 * 64 + cb * 16), pb, o1);
    }
    const float* sp = pscale + G * 64 + hi * 16;
#pragma unroll
    for (int r = 0; r < 16; ++r) { o0[r] *= sp[r]; o1[r] *= sp[32 + r]; }
    gated_store(o0, o1, 1.f, gl, lane, MIXED + row * MIXP + MIX_POOL + G * 64 + hi * 16);
}
struct Args { const float* x; const float* mem; const float* norm_g; const float* w_in; const float* pool_w; const float* pool_scale; const float* mem_norm_g;
              const float* w_mem_kv; const float* q_norm_g; const float* k_norm_g; const float* w_out; float* out; unsigned char* ws; };
__global__ void __launch_bounds__(512, 2) fwd_kernel(Args a) {
    extern __shared__ __attribute__((aligned(16))) unsigned char lds[];
    const int tid = threadIdx.x, lane = tid & 63, wave = __builtin_amdgcn_readfirstlane(tid >> 6);
    const int G = gridDim.x, bx = blockIdx.x;
    const int gw = bx * 8 + wave, gws = wave * G + bx, NGW = G * 8;
    unsigned char* ws = a.ws;
    bf16* XN = (bf16*)(ws + WS_XN); bf16* PROJ = (bf16*)(ws + WS_PROJ); bf16* VT = (bf16*)(ws + WS_VT); bf16* MIXED = (bf16*)(ws + WS_MIXED);
    bf16* WIN = (bf16*)(ws + WS_WIN); bf16* WV = (bf16*)(ws + WS_WV); bf16* WOUT = (bf16*)(ws + WS_WOUT); bf16* WKV = (bf16*)(ws + WS_WKV);
    bf16* MN = (bf16*)(ws + WS_MN); bf16* KM = (bf16*)(ws + WS_KM); bf16* VMT = (bf16*)(ws + WS_VMT); bf16* PWT = (bf16*)(ws + WS_PWT);
    PG8_LAS unsigned char* L = (PG8_LAS unsigned char*)lds;
    volatile LAS unsigned* MISC = (volatile LAS unsigned*)(L + 131072);
    if (tid < 64) MISC[tid] = 0u;
    __syncthreads();
    const XcdBarrier bar = xcd_barrier_post(g_bar_words, MISC);
    XcdBarrier barB = bar; barB.bar = g_bar_words + XCD_BAR_WORDS;
    unsigned* const lw = g_bar_words + 2 * XCD_BAR_WORDS;
    if (tid == 0 && (bar.x != (unsigned)(bx & 7) || G != 256)) __hip_atomic_fetch_or(&lw[XB_FLAG], 1u, __ATOMIC_RELAXED, __HIP_MEMORY_SCOPE_AGENT);

    {
        LAS float* scr = (LAS float*)(L + wave * 16384);
        constexpr int I_IN = (DM / 32) * (IN_WIDTH / 64), I_OUT = (DM / 32) * (DM / 64), I_KV = (DM / 32) * (512 / 64), I_PW = 4 * 2;
        constexpr int NITEMS = I_IN + I_OUT + I_KV + I_PW;
        for (int it = gws; it < NITEMS; it += NGW) {
            int r = it;
            if (r < I_IN) { const int n0 = 64 * (r % (IN_WIDTH / 64));
                if (n0 >= 1536 && n0 < 2048) p0_transpose_item(a.w_in, DM, IN_WIDTH, WV, -1536, scr, r, lane);
                else p0_transpose_item(a.w_in, DM, IN_WIDTH, WIN, n0 >= 2048 ? -512 : 0, scr, r, lane);
                continue; } r -= I_IN;
            if (r < I_OUT) { p0_transpose_item(a.w_out, DM, DM, WOUT, 0, scr, r, lane); continue; } r -= I_OUT;
            if (r < I_KV) { p0_transpose_item(a.w_mem_kv, DM, 512, WKV, 0, scr, r, lane, 1); continue; } r -= I_KV;
            { const int g = r >> 1; p0_transpose_item(a.pool_w + g * 4096, 64, 64, PWT + g * 4096, 0, scr, r & 1, lane); }
        }
        for (int m = gw; m < MROWS; m += NGW) rms_row_to_img(a.mem, a.mem_norm_g, MN, m, lane);
        for (int m = gw; m < MTOK; m += 4 * NGW) rms_rows_to_bf16<4>(a.x, a.norm_g, XN, m, NGW, MTOK, lane);
    }
    xcd_barrier(bar);
    const bool local_ok = __hip_atomic_load(&lw[XB_FLAG], __ATOMIC_RELAXED, __HIP_MEMORY_SCOPE_AGENT) == 0u;
    {
        pg8::Gemm g{XN, WIN, MTOK, PITCH, DM, DM, WV, XN}; pg8::DualOrder S; S.init(MTOK, PITCH, 512, MTOK, G, bx);
        pg8::EpiProjAll E{pg8::EpiImg{PROJ, C2}, pg8::EpiVblk{VT}};
        pg8::gemm_phase<pg8::EpiProjAll, pg8::DualOrder, true, true>(L, g, S, E);
    }
    for (int base = bx * 2; base < 512; base += G * 2) {
        int tile = base + (wave >> 2); const int kq = wave & 3;
        if (G == 256) { const int s = 2 * (bx >> 3) + (wave >> 2); tile = (s >> 5) * 256 + (8 * (bx & 7) + ((s >> 2) & 7)) * 4 + (s & 3); }
        f32x16 a0 = {}, a1 = {};
        memkv_partial(MN, WKV, tile, kq, lane, a0, a1);
        LAS float* red = (LAS float*)L + wave * 2048;
        if (kq != 0) {
#pragma unroll
            for (int r = 0; r < 16; ++r) { red[r * 64 + lane] = a0[r]; red[(16 + r) * 64 + lane] = a1[r]; } }
        __syncthreads();
        if (kq == 0) {
#pragma unroll
            for (int q = 1; q < 4; ++q)
#pragma unroll
                for (int r = 0; r < 16; ++r) { a0[r] += red[q * 2048 + r * 64 + lane]; a1[r] += red[q * 2048 + (16 + r) * 64 + lane]; }
            memkv_epilogue(a.k_norm_g, KM, VMT, tile, lane, a0, a1); }
        __syncthreads();
    }
    if (local_ok) xcd_barrier_local(bar, lw); else xcd_barrier(barB);
    LAS unsigned char* GL = L + 65536 + wave * 4096;
    const int gwv = (((G & 7) == 0) ? (bx & 7) * (G >> 3) + (bx >> 3) : bx) * 8 + wave;
#define P2_STAGE_K(u_) do { const bf16* kb_ = KM + (size_t)(((u_) >> 8) * 4 + (((u_) >> 6) & 3)) * (8 * 4 * 512) + lane * 8; \
        _Pragma("unroll") for (int f_ = 0; f_ < 4; ++f_) dma16(kb_ + (wave * 4 + f_) * 512, L + 98304 + (wave * 4 + f_) * 1024); } while (0)
    P2_STAGE_K(gwv);
    asm volatile("s_waitcnt vmcnt(0)" ::: "memory");
    __syncthreads();
    for (int u = gwv; u < BATCH * 8 * 32; u += NGW) { const int bh = u >> 5, i = u & 31;
#pragma unroll 1
        for (int rep = 0; rep < 2; ++rep) sb_unit(PROJ, VT, MIXED, bh >> 3, bh & 7, rep ? i : 63 - i, lane, L + wave * 8192, GL); }
    for (int u = gwv; u < BATCH * 4 * 64; u += NGW) {
        if (u != gwv) { __syncthreads(); P2_STAGE_K(u); asm volatile("s_waitcnt vmcnt(0)" ::: "memory"); __syncthreads(); }
        mem_unit(PROJ, KM, VMT, a.q_norm_g, MIXED, u >> 8, (u >> 6) & 3, u & 63, lane, GL, L + 98304); }
#undef P2_STAGE_K
    for (int u = gwv; u < (MTOK / 32) * 4; u += NGW) { const int pt = u >> 2, gs = u & 3, g = (pt & 1) ? 3 - gs : gs;
        if (g == 0) pool_unit<0>(PROJ, PWT, a.pool_scale, MIXED, pt, lane, GL, L + wave * 8192); else if (g == 1) pool_unit<1>(PROJ, PWT, a.pool_scale, MIXED, pt, lane, GL, L + wave * 8192);
        else if (g == 2) pool_unit<2>(PROJ, PWT, a.pool_scale, MIXED, pt, lane, GL, L + wave * 8192); else pool_unit<3>(PROJ, PWT, a.pool_scale, MIXED, pt, lane, GL, L + wave * 8192); }
    if (local_ok) xcd_barrier_local(bar, lw); else xcd_barrier(barB);
    {
        pg8::Gemm g{MIXED, WOUT, MTOK, DM, DM, MIXP, nullptr, nullptr}; pg8::StaticOrder S; S.init(MTOK, DM, G, bx);
        pg8::EpiResF32 E{a.x, a.out, DM, L + 131072 + 1024};
        pg8::gemm_phase<pg8::EpiResF32, pg8::StaticOrder, true, true>(L, g, S, E);
    }
}

extern "C" void kernel_launch(void* const* d_in, const int* in_sizes, int n_in, void* d_out, int out_size, void* d_ws, size_t ws_size, hipStream_t stream) {
    static int grid = 0;
    if (grid == 0) {
        if (n_in != 11 || out_size != MTOK * DM || ws_size < WS_END) { fprintf(stderr, "kernel_launch: unexpected shapes (n_in %d out %d ws %zu)\n", n_in, out_size, ws_size); grid = -1; return; }
        int dev = 0, cus = 0, per_cu = 0;
        hipGetDevice(&dev); hipDeviceGetAttribute(&cus, hipDeviceAttributeMultiprocessorCount, dev);
        hipFuncSetAttribute((const void*)fwd_kernel, hipFuncAttributeMaxDynamicSharedMemorySize, LDS_BYTES);
        hipOccupancyMaxActiveBlocksPerMultiprocessor(&per_cu, (const void*)fwd_kernel, 512, LDS_BYTES);
        if (per_cu < 1) { fprintf(stderr, "kernel_launch: occupancy query reports %d blocks per CU\n", per_cu); per_cu = 1; }
        grid = cus;
    }
    if (grid < 0) return;
    const size_t ws_off = (ws_size - WS_END) & ~(size_t)0xFFFFF;
    Args a{};
    a.x = (const float*)d_in[0]; a.mem = (const float*)d_in[1]; a.norm_g = (const float*)d_in[2]; a.w_in = (const float*)d_in[3]; a.pool_w = (const float*)d_in[4];
    a.pool_scale = (const float*)d_in[5]; a.mem_norm_g = (const float*)d_in[6]; a.w_mem_kv = (const float*)d_in[7]; a.q_norm_g = (const float*)d_in[8];
    a.k_norm_g = (const float*)d_in[9]; a.w_out = (const float*)d_in[10]; a.out = (float*)d_out; a.ws = (unsigned char*)d_ws + ws_off;
    void* args[] = {&a};
    hipError_t e = hipLaunchCooperativeKernel((const void*)fwd_kernel, dim3(grid), dim3(512), args, LDS_BYTES, stream);
    if (e != hipSuccess) fprintf(stderr, "cooperative launch failed: %s (grid %d)\n", hipGetErrorString(e), grid);
}
```
